# Optimizing an MI355X kernel written in HIP

```python
import math
import jax
import jax.numpy as jnp
from jax import lax
import numpy as np

D_MODEL = 1024
BATCH = 8
SEQ = 8192
DEPTH = 1

DA_HEADS = 4
DA_HEAD_DIM = 64
DA_V_DIM = 2 * DA_HEAD_DIM
GLA_HEADS = 4
GLA_DK = 64
GLA_DV = 128
GLA_GATE_RANK = 16
GLA_TAU = 16.0
GLA_CHUNK = 64
MEM_LEN = 256
XA_HEADS = 4
XA_HEAD_DIM = 128
N_BRANCH = 3
PEER_HEADS = 8
PEER_N_KEYS = 128
PEER_N_EXPERTS = PEER_N_KEYS * PEER_N_KEYS
PEER_QDIM = 256
PEER_TOPK = 16
PEER_TOKEN_BLOCK = 128
Q_BLOCK = 128
RMS_EPS = 1e-6
D_IN_PROJ = (3 * DA_HEADS * 2 * DA_HEAD_DIM + 2 * GLA_HEADS * GLA_DK + 2 * GLA_HEADS * GLA_DV + GLA_GATE_RANK + XA_HEADS * XA_HEAD_DIM + N_BRANCH * D_MODEL)

kernel_name = "hybrid_diffattn_gla_memxattn_peer"


def _in_proj_splits():
    sizes = [DA_HEADS * 2 * DA_HEAD_DIM, DA_HEADS * 2 * DA_HEAD_DIM, DA_HEADS * DA_V_DIM,
             GLA_HEADS * GLA_DK, GLA_HEADS * GLA_DK, GLA_HEADS * GLA_DV, GLA_HEADS * GLA_DV, GLA_GATE_RANK,
             XA_HEADS * XA_HEAD_DIM, N_BRANCH * D_MODEL]
    splits, acc = [], 0
    for s in sizes[:-1]:
        acc += s
        splits.append(acc)
    return splits


def _rmsnorm(t, w):
    tf = t.astype(jnp.float32)
    y = tf * lax.rsqrt(jnp.mean(tf * tf, axis=-1, keepdims=True) + RMS_EPS)
    return (y * w.astype(jnp.float32)).astype(t.dtype)


def _alibi_slopes(n_heads):
    return jnp.exp2(-8.0 * jnp.arange(1, n_heads + 1, dtype=jnp.float32) / n_heads)


def _diff_attention(q, k, v, lam, slopes):
    B, H, _, S, d = q.shape
    nblk = S // Q_BLOCK
    kpos = jnp.arange(S, dtype=jnp.int32)
    scale = d ** -0.5
    q_blocks = q.reshape(B, H, 2, nblk, Q_BLOCK, d).transpose(3, 0, 1, 2, 4, 5)

    def block(args):
        q_blk, i = args
        qpos = i * Q_BLOCK + jnp.arange(Q_BLOCK, dtype=jnp.int32)
        dist = qpos[:, None] - kpos[None, :]
        bias = -slopes[:, None, None] * dist.astype(jnp.float32)[None]
        s = jnp.einsum('bhmqd,bhmkd->bhmqk', q_blk, k).astype(jnp.float32) * scale + bias[None, :, None]
        s = jnp.where(dist[None, None, None] >= 0, s, -jnp.inf)
        p = jax.nn.softmax(s, axis=-1)
        w = p[:, :, 0] - lam * p[:, :, 1]
        return jnp.einsum('bhqk,bhkv->bhqv', w.astype(v.dtype), v)

    out = lax.map(block, (q_blocks, jnp.arange(nblk, dtype=jnp.int32)))
    return out.transpose(1, 2, 0, 3, 4).reshape(B, H, S, v.shape[-1])


def _gla(q, k, v, log_a):
    B, S, H, dk = q.shape
    dv = v.shape[-1]
    C = GLA_CHUNK
    n = S // C
    out_dtype = v.dtype

    def to_chunks(t):
        return t.astype(jnp.float32).reshape(B, n, C, H, t.shape[-1]).transpose(1, 0, 3, 2, 4)

    qc, kc, vc, gc = to_chunks(q * (dk ** -0.5)), to_chunks(k), to_chunks(v), to_chunks(log_a)
    causal = jnp.tril(jnp.ones((C, C), dtype=bool))

    def step(state, inp):
        qt, kt, vt, gt = inp
        b = jnp.cumsum(gt, axis=2)
        o_inter = jnp.einsum('bhcd,bhde->bhce', qt * jnp.exp(b), state)
        diff = b[:, :, :, None, :] - b[:, :, None, :, :]
        decay = jnp.exp(jnp.where(causal[:, :, None], diff, -jnp.inf))
        a = jnp.einsum('bhtd,bhsd,bhtsd->bhts', qt, kt, decay)
        o_intra = jnp.einsum('bhts,bhse->bhte', a, vt)
        b_last = b[:, :, -1:, :]
        k_dec = kt * jnp.exp(b_last - b)
        state = state * jnp.exp(b_last[:, :, 0, :])[..., None] + jnp.einsum('bhcd,bhce->bhde', k_dec, vt)
        return state, o_inter + o_intra

    state0 = jnp.zeros((B, H, dk, dv), jnp.float32)
    _, o = lax.scan(step, state0, (qc, kc, vc, gc))
    return o.transpose(1, 0, 3, 2, 4).reshape(B, S, H, dv).astype(out_dtype)


def _mem_attention(q, k, v):
    d = q.shape[-1]
    s = jnp.einsum('bshd,bmhd->bhsm', q, k).astype(jnp.float32) * (d ** -0.5)
    p = jax.nn.softmax(s, axis=-1)
    return jnp.einsum('bhsm,bmhd->bshd', p.astype(v.dtype), v)


def _peer(xn, w_q, sub_keys, expert_u, expert_v):
    B, S, D = xn.shape
    T = PEER_TOKEN_BLOCK
    K = PEER_TOPK
    H = PEER_HEADS
    x_blocks = xn.reshape(-1, T, D)

    def block(xb):
        q = (xb @ w_q).reshape(T, H, 2, PEER_QDIM // 2)
        s = jnp.einsum('thpc,pnc->thpn', q, sub_keys).astype(jnp.float32)
        top_s, top_i = lax.top_k(s, K)
        cand_s = top_s[:, :, 0, :, None] + top_s[:, :, 1, None, :]
        cand_i = top_i[:, :, 0, :, None] * PEER_N_KEYS + top_i[:, :, 1, None, :]
        best_s, best_j = lax.top_k(cand_s.reshape(T, H, K * K), K)
        idx = jnp.take_along_axis(cand_i.reshape(T, H, K * K), best_j, axis=-1)
        g = jax.nn.softmax(best_s, axis=-1)
        u = expert_u[idx]
        v = expert_v[idx]
        act = jax.nn.gelu(jnp.einsum('thkd,td->thk', u, xb).astype(jnp.float32), approximate=False)
        return jnp.einsum('thk,thkd->td', (g * act).astype(xb.dtype), v)

    return lax.map(block, x_blocks).reshape(B, S, D)


def setup_inputs(seed: int = 0) -> dict:
    key = jax.random.key(seed)
    ks = iter(jax.random.split(key, 32))
    L, D = DEPTH, D_MODEL
    f32 = jnp.float32

    def nrm(shape, scale):
        return jax.random.normal(next(ks), shape, f32) * scale

    def gain(shape):
        return 1.0 + 0.02 * jax.random.normal(next(ks), shape, f32)

    da_w = DA_HEADS * DA_V_DIM
    gla_w = GLA_HEADS * GLA_DV
    xa_w = XA_HEADS * XA_HEAD_DIM
    return {
        'x': nrm((BATCH, SEQ, D), 1.0),
        'mem': nrm((BATCH, MEM_LEN, D), 1.0),
        'mix_norm_w': gain((L, D)),
        'w_in': nrm((L, D, D_IN_PROJ), D ** -0.5),
        'da_q_norm_w': gain((L, DA_HEAD_DIM)),
        'da_k_norm_w': gain((L, DA_HEAD_DIM)),
        'da_lambda': nrm((L, 4, DA_HEAD_DIM), 0.1),
        'da_out_norm_w': gain((L, DA_V_DIM)),
        'gla_w_gate': nrm((L, GLA_GATE_RANK, GLA_HEADS * GLA_DK), GLA_GATE_RANK ** -0.5),
        'gla_b_gate': nrm((L, GLA_HEADS * GLA_DK), 0.01),
        'gla_out_norm_w': gain((L, GLA_DV)),
        'mem_norm_w': gain((L, D)),
        'w_mem_kv': nrm((L, D, 2 * xa_w), D ** -0.5),
        'xa_q_norm_w': gain((L, XA_HEAD_DIM)),
        'xa_k_norm_w': gain((L, XA_HEAD_DIM)),
        'w_br_da': nrm((L, da_w, D), da_w ** -0.5),
        'w_br_gla': nrm((L, gla_w, D), gla_w ** -0.5),
        'w_br_xa': nrm((L, xa_w, D), xa_w ** -0.5),
        'w_out': nrm((L, D, D), D ** -0.5),
        'ffn_norm_w': gain((L, D)),
        'peer_w_q': nrm((L, D, PEER_HEADS * PEER_QDIM), D ** -0.5),
        'peer_sub_keys': nrm((L, 2, PEER_N_KEYS, PEER_QDIM // 2), (PEER_QDIM // 2) ** -0.5),
        'peer_u': nrm((L, PEER_N_EXPERTS, D), D ** -0.5),
        'peer_v': nrm((L, PEER_N_EXPERTS, D), 0.1),
    }


def reference(x, mem, mix_norm_w, w_in, da_q_norm_w, da_k_norm_w, da_lambda, da_out_norm_w,
              gla_w_gate, gla_b_gate, gla_out_norm_w, mem_norm_w, w_mem_kv, xa_q_norm_w, xa_k_norm_w,
              w_br_da, w_br_gla, w_br_xa, w_out, ffn_norm_w, peer_w_q, peer_sub_keys, peer_u, peer_v):
    B, S, D = x.shape
    M = mem.shape[1]
    slopes = _alibi_slopes(DA_HEADS)
    splits = _in_proj_splits()
    for l in range(DEPTH):
        xn = _rmsnorm(x, mix_norm_w[l])
        proj = xn @ w_in[l]
        (da_q, da_k, da_v, gl_q, gl_k, gl_v, gl_r, gl_g, xa_q, gate_logits) = jnp.split(proj, splits, axis=-1)

        dq = _rmsnorm(da_q.reshape(B, S, DA_HEADS, 2, DA_HEAD_DIM), da_q_norm_w[l]).transpose(0, 2, 3, 1, 4)
        dk = _rmsnorm(da_k.reshape(B, S, DA_HEADS, 2, DA_HEAD_DIM), da_k_norm_w[l]).transpose(0, 2, 3, 1, 4)
        dv = da_v.reshape(B, S, DA_HEADS, DA_V_DIM).transpose(0, 2, 1, 3)
        lam_init = 0.8 - 0.6 * math.exp(-0.3 * l)
        lvec = da_lambda[l].astype(jnp.float32)
        lam = jnp.exp(jnp.sum(lvec[0] * lvec[1])) - jnp.exp(jnp.sum(lvec[2] * lvec[3])) + lam_init
        o_da = _diff_attention(dq, dk, dv, lam, slopes)
        o_da = (_rmsnorm(o_da, da_out_norm_w[l]) * (1.0 - lam_init)).transpose(0, 2, 1, 3).reshape(B, S, DA_HEADS * DA_V_DIM)

        log_a = jax.nn.log_sigmoid((gl_g @ gla_w_gate[l] + gla_b_gate[l]).astype(jnp.float32)) / GLA_TAU
        o_gla = _gla(gl_q.reshape(B, S, GLA_HEADS, GLA_DK), gl_k.reshape(B, S, GLA_HEADS, GLA_DK),
                     gl_v.reshape(B, S, GLA_HEADS, GLA_DV), log_a.reshape(B, S, GLA_HEADS, GLA_DK))
        o_gla = _rmsnorm(o_gla, gla_out_norm_w[l]).reshape(B, S, GLA_HEADS * GLA_DV) * jax.nn.silu(gl_r)

        mem_n = _rmsnorm(mem, mem_norm_w[l])
        mk, mv = jnp.split(mem_n @ w_mem_kv[l], 2, axis=-1)
        xq = _rmsnorm(xa_q.reshape(B, S, XA_HEADS, XA_HEAD_DIM), xa_q_norm_w[l])
        mk = _rmsnorm(mk.reshape(B, M, XA_HEADS, XA_HEAD_DIM), xa_k_norm_w[l])
        mv = mv.reshape(B, M, XA_HEADS, XA_HEAD_DIM)
        o_xa = _mem_attention(xq, mk, mv).reshape(B, S, XA_HEADS * XA_HEAD_DIM)

        g = jax.nn.sigmoid(gate_logits.astype(jnp.float32)).astype(x.dtype).reshape(B, S, N_BRANCH, D)
        merged = (g[:, :, 0] * (o_da @ w_br_da[l]) + g[:, :, 1] * (o_gla @ w_br_gla[l])
                  + g[:, :, 2] * (o_xa @ w_br_xa[l]))
        x = x + merged @ w_out[l]

        x = x + _peer(_rmsnorm(x, ffn_norm_w[l]), peer_w_q[l], peer_sub_keys[l], peer_u[l], peer_v[l])
    return x
```

```cpp
#include <hip/hip_runtime.h>
#include <hip/hip_cooperative_groups.h>
#include <cstdio>
namespace cg = cooperative_groups;

#define DI __device__ __forceinline__
typedef unsigned short bf16_t;
typedef short bf16x8 __attribute__((ext_vector_type(8)));
typedef short s16x4 __attribute__((ext_vector_type(4)));
typedef float f32x4 __attribute__((ext_vector_type(4)));
typedef unsigned u32x4 __attribute__((ext_vector_type(4)));
typedef unsigned u32x2 __attribute__((ext_vector_type(2)));
typedef __bf16 bf2_t __attribute__((ext_vector_type(2)));

constexpr int T_ = 65536, S_ = 8192;
constexpr float EPS = 1e-6f;
constexpr float LOG2E = 1.4426950408889634f;
constexpr size_t MiB = 1ull << 20;
constexpr size_t OFF_WIN = 0, OFF_WG = 8 * MiB, OFF_WMEM = 14 * MiB, OFF_WBR = 16 * MiB, OFF_WOUT = 20 * MiB, OFF_WQ = 22 * MiB,
                 OFF_SUBK = 26 * MiB, OFF_MISC = 27 * MiB, OFF_MEMN = 28 * MiB, OFF_MK = 32 * MiB, OFF_MVT = 34 * MiB, OFF_GLG = 36 * MiB,
                 OFF_DEC = 40 * MiB, OFF_U = 48 * MiB, OFF_V = 80 * MiB, OFF_DAQ = 112 * MiB, OFF_DAK = 176 * MiB, OFF_DAVT = 240 * MiB,
                 OFF_GLQ = 304 * MiB, OFF_GLK = 336 * MiB, OFF_GLV = 368 * MiB, OFF_GLR = 432 * MiB, OFF_XAQ = 496 * MiB, OFF_MERGED = 560 * MiB;
constexpr size_t OFF_XN2 = OFF_DAK, OFF_PIDX = OFF_GLQ, OFF_PG = OFF_GLK;
constexpr size_t OUT_XN = 0, OUT_ST = 128 * MiB;

struct P {
  const float *x, *mem, *mix_norm_w, *w_in, *da_q_norm_w, *da_k_norm_w, *da_lambda, *da_out_norm_w, *gla_w_gate, *gla_b_gate,
      *gla_out_norm_w, *mem_norm_w, *w_mem_kv, *xa_q_norm_w, *xa_k_norm_w, *w_br_da, *w_br_gla, *w_br_xa, *w_out, *ffn_norm_w,
      *peer_w_q, *peer_sub_keys, *peer_u, *peer_v;
  float* out;
  char* ws;
  int phase_lo, phase_hi;
};

DI bf16_t f2bf(float f) { unsigned u = __float_as_uint(f); u += 0x7fffu + ((u >> 16) & 1u); return (bf16_t)(u >> 16); }
DI float bf2f(bf16_t h) { return __uint_as_float(((unsigned)h) << 16); }
DI unsigned pack2(float a, float b) { return (unsigned)f2bf(a) | ((unsigned)f2bf(b) << 16); }
DI float lo2f(unsigned u) { return __uint_as_float(u << 16); }
DI float hi2f(unsigned u) { return __uint_as_float(u & 0xffff0000u); }
DI f32x4 mfma16(bf16x8 a, bf16x8 b, f32x4 c) { return __builtin_amdgcn_mfma_f32_16x16x32_bf16(a, b, c, 0, 0, 0); }
DI float fexp2(float x) { return __builtin_amdgcn_exp2f(x); }
DI float frcp(float x) { return __builtin_amdgcn_rcpf(x); }
DI float xor16(float v) { return __shfl_xor(v, 16); }
DI float xor32(float v) { return __shfl_xor(v, 32); }
DI float quadsum(float v) { v += __shfl_xor(v, 16); v += __shfl_xor(v, 32); return v; }
DI float quadmax(float v) { v = fmaxf(v, __shfl_xor(v, 16)); v = fmaxf(v, __shfl_xor(v, 32)); return v; }
DI float wavesum(float v) {
#pragma unroll
  for (int o = 32; o > 0; o >>= 1) v += __shfl_xor(v, o);
  return v;
}

constexpr int LDT = 72;
template <bool PREFETCH = true>
DI void gemm_tile(const bf16_t* __restrict__ A, long lda, const bf16_t* __restrict__ Bt, long ldb, int K, f32x4 (&acc)[2][8], bf16_t* sA, bf16_t* sB) {
  const int tid = threadIdx.x, lane = tid & 63, w = tid >> 6, r16 = lane & 15, quad = lane >> 4;
  u32x4 ra[4], rb[4];
  const int lrow = tid >> 3, lkc = (tid & 7) * 8;
  if (PREFETCH) {
#pragma unroll
    for (int i = 0; i < 4; i++) {
      ra[i] = *(const u32x4*)(A + (long)(lrow + 32 * i) * lda + lkc);
      rb[i] = *(const u32x4*)(Bt + (long)(lrow + 32 * i) * ldb + lkc);
    }
  }
#pragma unroll 1
  for (int k0 = 0; k0 < K; k0 += 64) {
    if (!PREFETCH) {
#pragma unroll
      for (int i = 0; i < 4; i++) {
        ra[i] = *(const u32x4*)(A + (long)(lrow + 32 * i) * lda + k0 + lkc);
        rb[i] = *(const u32x4*)(Bt + (long)(lrow + 32 * i) * ldb + k0 + lkc);
      }
    }
    __syncthreads();
#pragma unroll
    for (int i = 0; i < 4; i++) {
      *(u32x4*)(sA + (lrow + 32 * i) * LDT + lkc) = ra[i];
      *(u32x4*)(sB + (lrow + 32 * i) * LDT + lkc) = rb[i];
    }
    __syncthreads();
    if (PREFETCH && k0 + 64 < K) {
#pragma unroll
      for (int i = 0; i < 4; i++) {
        ra[i] = *(const u32x4*)(A + (long)(lrow + 32 * i) * lda + k0 + 64 + lkc);
        rb[i] = *(const u32x4*)(Bt + (long)(lrow + 32 * i) * ldb + k0 + 64 + lkc);
      }
    }
    __builtin_amdgcn_sched_barrier(0);
#pragma unroll
    for (int ks = 0; ks < 2; ks++) {
      bf16x8 af[2];
#pragma unroll
      for (int mt = 0; mt < 2; mt++) af[mt] = *(const bf16x8*)(sA + (32 * w + 16 * mt + r16) * LDT + ks * 32 + quad * 8);
#pragma unroll
      for (int nt = 0; nt < 8; nt++) {
        bf16x8 bfr = *(const bf16x8*)(sB + (16 * nt + r16) * LDT + ks * 32 + quad * 8);
#pragma unroll
        for (int mt = 0; mt < 2; mt++) acc[mt][nt] = mfma16(bfr, af[mt], acc[mt][nt]);
      }
      __builtin_amdgcn_sched_barrier(0);
    }
  }
}
DI void zero_acc(f32x4 (&acc)[2][8]) {
#pragma unroll
  for (int a = 0; a < 2; a++)
#pragma unroll
    for (int b = 0; b < 8; b++) acc[a][b] = f32x4{0.f, 0.f, 0.f, 0.f};
}

DI void transpose_convert(const float* __restrict__ src, int ldsrc, int col0, bf16_t* __restrict__ dst, int K, int n0, int ncols, long gtid, long gstride) {
  const long total = (long)ncols * (K / 8);
  for (long idx = gtid; idx < total; idx += gstride) {
    const int n = (int)(idx % ncols), kc = (int)(idx / ncols);
    unsigned pk[4];
#pragma unroll
    for (int j = 0; j < 4; j++) {
      float a = src[(long)(kc * 8 + 2 * j) * ldsrc + col0 + n];
      float b = src[(long)(kc * 8 + 2 * j + 1) * ldsrc + col0 + n];
      pk[j] = pack2(a, b);
    }
    *(u32x4*)(dst + (long)(n0 + n) * K + kc * 8) = u32x4{pk[0], pk[1], pk[2], pk[3]};
  }
}
DI void convert_flat(const float* __restrict__ src, bf16_t* __restrict__ dst, long n, long gtid, long gstride) {
  for (long i = gtid; i < n / 8; i += gstride) {
    f32x4 a = ((const f32x4*)src)[2 * i], b = ((const f32x4*)src)[2 * i + 1];
    ((u32x4*)dst)[i] = u32x4{pack2(a.x, a.y), pack2(a.z, a.w), pack2(b.x, b.y), pack2(b.z, b.w)};
  }
}
DI void rmsnorm_rows(const float* __restrict__ src, const float* __restrict__ w, bf16_t* __restrict__ dst, int nrows, int gwave, int nwaves) {
  const int lane = threadIdx.x & 63;
  for (int r = gwave; r < nrows; r += nwaves) {
    const f32x4* s4 = (const f32x4*)(src + (long)r * 1024);
    f32x4 v[4];
    float ss = 0.f;
#pragma unroll
    for (int j = 0; j < 4; j++) { v[j] = s4[j * 64 + lane]; ss += v[j].x * v[j].x + v[j].y * v[j].y + v[j].z * v[j].z + v[j].w * v[j].w; }
    ss = wavesum(ss);
    const float rstd = rsqrtf(ss * (1.f / 1024.f) + EPS);
#pragma unroll
    for (int j = 0; j < 4; j++) {
      f32x4 ww = ((const f32x4*)w)[j * 64 + lane];
      u32x2 o = u32x2{pack2(v[j].x * rstd * ww.x, v[j].y * rstd * ww.y), pack2(v[j].z * rstd * ww.z, v[j].w * rstd * ww.w)};
      *(u32x2*)(dst + (long)r * 1024 + (j * 64 + lane) * 4) = o;
    }
  }
}

DI void phase0(const P& p) {
  const long gtid = (long)blockIdx.x * blockDim.x + threadIdx.x, gstride = (long)gridDim.x * blockDim.x;
  char* ws = p.ws;
  bf16_t* win = (bf16_t*)(ws + OFF_WIN);
  transpose_convert(p.w_in, 6672, 0, win, 1024, 0, 3072, gtid, gstride);
  transpose_convert(p.w_in, 6672, 3088, win, 1024, 3072, 512, gtid, gstride);
  transpose_convert(p.w_in, 6672, 3072, win, 1024, 3584, 16, gtid, gstride);
  for (long i = gtid; i < 112 * 1024 / 8; i += gstride) ((u32x4*)(win + 3600 * 1024))[i] = u32x4{0, 0, 0, 0};
  transpose_convert(p.w_in, 6672, 3600, (bf16_t*)(ws + OFF_WG), 1024, 0, 3072, gtid, gstride);
  transpose_convert(p.w_mem_kv, 1024, 0, (bf16_t*)(ws + OFF_WMEM), 1024, 0, 1024, gtid, gstride);
  transpose_convert(p.w_br_da, 1024, 0, (bf16_t*)(ws + OFF_WBR), 512, 0, 1024, gtid, gstride);
  transpose_convert(p.w_br_gla, 1024, 0, (bf16_t*)(ws + OFF_WBR + MiB), 512, 0, 1024, gtid, gstride);
  transpose_convert(p.w_br_xa, 1024, 0, (bf16_t*)(ws + OFF_WBR + 2 * MiB), 512, 0, 1024, gtid, gstride);
  transpose_convert(p.w_out, 1024, 0, (bf16_t*)(ws + OFF_WOUT), 1024, 0, 1024, gtid, gstride);
  transpose_convert(p.peer_w_q, 2048, 0, (bf16_t*)(ws + OFF_WQ), 1024, 0, 2048, gtid, gstride);
  convert_flat(p.peer_sub_keys, (bf16_t*)(ws + OFF_SUBK), 2 * 128 * 128, gtid, gstride);
  convert_flat(p.peer_u, (bf16_t*)(ws + OFF_U), 16384l * 1024, gtid, gstride);
  convert_flat(p.peer_v, (bf16_t*)(ws + OFF_V), 16384l * 1024, gtid, gstride);
  const int gwave = (int)(gtid >> 6), nwaves = (int)(gstride >> 6);
  rmsnorm_rows(p.x, p.mix_norm_w, (bf16_t*)((char*)p.out + OUT_XN), T_, gwave, nwaves);
  rmsnorm_rows(p.mem, p.mem_norm_w, (bf16_t*)(ws + OFF_MEMN), 2048, gwave, nwaves);
  if (gtid == 0) {
    float s0 = 0.f, s1 = 0.f;
    for (int i = 0; i < 64; i++) { s0 += p.da_lambda[i] * p.da_lambda[64 + i]; s1 += p.da_lambda[128 + i] * p.da_lambda[192 + i]; }
    float* misc = (float*)(ws + OFF_MISC);
    misc[0] = expf(s0) - expf(s1) + 0.2f;
    ((unsigned*)misc)[16] = 0u;
  }
}

constexpr int NT_IN = 29, N_INPROJ_TILES = 512 * NT_IN, N_MEMKV_TILES = 16 * 8;

template <int GS>
DI void epi_norm_store(const f32x4 (&acc)[2][8], const float* __restrict__ w, float scale, bf16_t* __restrict__ dst, long ldd, int w_, int r16, int quad) {
#pragma unroll
  for (int mt = 0; mt < 2; mt++) {
    const int m = 32 * w_ + 16 * mt + r16;
#pragma unroll
    for (int g = 0; g < 128 / GS; g++) {
      float ss = 0.f;
#pragma unroll
      for (int nt = g * (GS / 16); nt < (g + 1) * (GS / 16); nt++)
#pragma unroll
        for (int i = 0; i < 4; i++) ss += acc[mt][nt][i] * acc[mt][nt][i];
      ss = quadsum(ss);
      const float rs = rsqrtf(ss * (1.f / GS) + EPS) * scale;
#pragma unroll
      for (int nt = g * (GS / 16); nt < (g + 1) * (GS / 16); nt++) {
        const int col = 16 * nt + 4 * quad;
        const f32x4 ww = *(const f32x4*)(w + (col & (GS - 1)));
        u32x2 o = u32x2{pack2(acc[mt][nt][0] * rs * ww.x, acc[mt][nt][1] * rs * ww.y), pack2(acc[mt][nt][2] * rs * ww.z, acc[mt][nt][3] * rs * ww.w)};
        *(u32x2*)(dst + (long)m * ldd + col) = o;
      }
    }
  }
}
DI void epi_plain_store(const f32x4 (&acc)[2][8], float scale, bf16_t* __restrict__ dst, long ldd, int w_, int r16, int quad) {
#pragma unroll
  for (int mt = 0; mt < 2; mt++) {
    const int m = 32 * w_ + 16 * mt + r16;
#pragma unroll
    for (int nt = 0; nt < 8; nt++) {
      const int col = 16 * nt + 4 * quad;
      u32x2 o = u32x2{pack2(acc[mt][nt][0] * scale, acc[mt][nt][1] * scale), pack2(acc[mt][nt][2] * scale, acc[mt][nt][3] * scale)};
      *(u32x2*)(dst + (long)m * ldd + col) = o;
    }
  }
}
DI void epi_trans_store(const f32x4 (&acc)[2][8], bf16_t* __restrict__ dst, long ldd, int w_, int r16, int quad, bf16_t* sT) {
  __syncthreads();
#pragma unroll
  for (int mt = 0; mt < 2; mt++) {
    const int m = 32 * w_ + 16 * mt + r16;
#pragma unroll
    for (int nt = 0; nt < 8; nt++)
#pragma unroll
      for (int i = 0; i < 4; i++) sT[(16 * nt + 4 * quad + i) * 136 + m] = f2bf(acc[mt][nt][i]);
  }
  __syncthreads();
  const int tid = threadIdx.x;
#pragma unroll
  for (int i = 0; i < 8; i++) {
    const int c = tid + 256 * i, n = c >> 4, mc = (c & 15) * 8;
    *(u32x4*)(dst + (long)n * ldd + mc) = *(const u32x4*)(sT + n * 136 + mc);
  }
}

DI void phase1_tile(const P& p, int tile, bf16_t* sA, bf16_t* sB) {
  const int tid = threadIdx.x, lane = tid & 63, w = tid >> 6, r16 = lane & 15, quad = lane >> 4;
  char* ws = p.ws;
  f32x4 acc[2][8];
  zero_acc(acc);
  if (tile < N_INPROJ_TILES) {
    const int xcd = tile & 7, j = tile >> 3, mp = (j / NT_IN) * 8 + xcd, nt_ = j % NT_IN;
    const bf16_t* A = (const bf16_t*)((const char*)p.out + OUT_XN) + (long)mp * 128 * 1024;
    const bf16_t* Bt = (const bf16_t*)(ws + OFF_WIN) + (long)nt_ * 128 * 1024;
    gemm_tile(A, 1024, Bt, 1024, 1024, acc, sA, sB);
    const long m0 = (long)mp * 128;
    if (nt_ < 4) {
      epi_norm_store<64>(acc, p.da_q_norm_w, 0.125f * LOG2E, (bf16_t*)(ws + OFF_DAQ) + m0 * 512 + nt_ * 128, 512, w, r16, quad);
    } else if (nt_ < 8) {
      epi_norm_store<64>(acc, p.da_k_norm_w, 1.f, (bf16_t*)(ws + OFF_DAK) + m0 * 512 + (nt_ - 4) * 128, 512, w, r16, quad);
    } else if (nt_ < 12) {
      const int b = (int)(m0 / S_), s0 = (int)(m0 % S_), h = nt_ - 8;
      epi_trans_store(acc, (bf16_t*)(ws + OFF_DAVT) + ((long)(b * 4 + h) * 128) * S_ + s0, S_, w, r16, quad, sA);
    } else if (nt_ < 14) {
      epi_plain_store(acc, 0.125f, (bf16_t*)(ws + OFF_GLQ) + m0 * 256 + (nt_ - 12) * 128, 256, w, r16, quad);
    } else if (nt_ < 16) {
      epi_plain_store(acc, 1.f, (bf16_t*)(ws + OFF_GLK) + m0 * 256 + (nt_ - 14) * 128, 256, w, r16, quad);
    } else if (nt_ < 20) {
      epi_plain_store(acc, 1.f, (bf16_t*)(ws + OFF_GLV) + m0 * 512 + (nt_ - 16) * 128, 512, w, r16, quad);
    } else if (nt_ < 24) {
      epi_plain_store(acc, 1.f, (bf16_t*)(ws + OFF_GLR) + m0 * 512 + (nt_ - 20) * 128, 512, w, r16, quad);
    } else if (nt_ < 28) {
      epi_norm_store<128>(acc, p.xa_q_norm_w, 0.08838834764831845f * LOG2E, (bf16_t*)(ws + OFF_XAQ) + m0 * 512 + (nt_ - 24) * 128, 512, w, r16, quad);
    } else {
      float* glg = (float*)(ws + OFF_GLG);
#pragma unroll
      for (int mt = 0; mt < 2; mt++) {
        const long m = m0 + 32 * w + 16 * mt + r16;
        *(f32x4*)(glg + m * 16 + 4 * quad) = acc[mt][0];
      }
    }
  } else {
    const int t2 = tile - N_INPROJ_TILES, mp = t2 >> 3, nt_ = t2 & 7;
    const bf16_t* A = (const bf16_t*)(ws + OFF_MEMN) + (long)mp * 128 * 1024;
    const bf16_t* Bt = (const bf16_t*)(ws + OFF_WMEM) + (long)nt_ * 128 * 1024;
    gemm_tile(A, 1024, Bt, 1024, 1024, acc, sA, sB);
    const long m0 = (long)mp * 128;
    if (nt_ < 4) {
      epi_norm_store<128>(acc, p.xa_k_norm_w, 1.f, (bf16_t*)(ws + OFF_MK) + m0 * 512 + nt_ * 128, 512, w, r16, quad);
    } else {
      const int b = (int)(m0 / 256), mm0 = (int)(m0 % 256), h = nt_ - 4;
      epi_trans_store(acc, (bf16_t*)(ws + OFF_MVT) + ((long)(b * 4 + h) * 128) * 256 + mm0, 256, w, r16, quad, sA);
    }
  }
}

constexpr int LDK = 136, LDV = 72;
template <int DQK, int NCOMP, bool CAUSAL, bool NORM>
DI void attn_item(const bf16_t* __restrict__ Q, int ldq, const bf16_t* __restrict__ Kp, int ldk, const bf16_t* __restrict__ VT, int ldv, int ntiles, int q0,
                  float slope2, float lam, const float* __restrict__ normw, float outscale, bf16_t* __restrict__ O, int ldo, bf16_t* sK, bf16_t* sV) {
  const int tid = threadIdx.x, lane = tid & 63, w = tid >> 6, r16 = lane & 15, quad = lane >> 4;
  constexpr int KS = DQK / 32;
  bf16x8 qf[NCOMP][KS];
#pragma unroll
  for (int c = 0; c < NCOMP; c++)
#pragma unroll
    for (int ks = 0; ks < KS; ks++) qf[c][ks] = *(const bf16x8*)(Q + (long)(16 * w + r16) * ldq + c * DQK + ks * 32 + quad * 8);
  f32x4 oacc[NCOMP][8];
  float mrun[NCOMP], lrun[NCOMP];
#pragma unroll
  for (int c = 0; c < NCOMP; c++) {
    mrun[c] = -1e30f; lrun[c] = 0.f;
#pragma unroll
    for (int et = 0; et < 8; et++) oacc[c][et] = f32x4{0.f, 0.f, 0.f, 0.f};
  }
  const int tq = q0 + 16 * w + r16;
  const int krow = tid >> 4, kkc = (tid & 15) * 8;
  const int vrow = tid >> 3, vkc = (tid & 7) * 8;
#pragma unroll 1
  for (int kt = 0; kt < ntiles; kt++) {
    {
      u32x4 rk[4], rv[4];
      const int k1 = kt * 64;
#pragma unroll
      for (int i = 0; i < 4; i++) {
        rk[i] = *(const u32x4*)(Kp + (long)(k1 + krow + 16 * i) * ldk + kkc);
        rv[i] = *(const u32x4*)(VT + (long)(vrow + 32 * i) * ldv + k1 + vkc);
      }
      __syncthreads();
#pragma unroll
      for (int i = 0; i < 4; i++) {
        *(u32x4*)(sK + (krow + 16 * i) * LDK + kkc) = rk[i];
        *(u32x4*)(sV + (vrow + 32 * i) * LDV + vkc) = rv[i];
      }
      __syncthreads();
    }
    __builtin_amdgcn_sched_barrier(0);
    const int k0 = kt * 64;
    if (CAUSAL && k0 > q0 + 16 * w + 15) continue;
    const bool diag = CAUSAL && (k0 + 63 > q0 + 16 * w);
#pragma unroll
    for (int c = 0; c < NCOMP; c++) {
      f32x4 s[4];
#pragma unroll
      for (int mt = 0; mt < 4; mt++) {
        if (CAUSAL) {
#pragma unroll
          for (int i = 0; i < 4; i++) s[mt][i] = slope2 * (float)(k0 + 16 * mt + 4 * quad + i - tq);
        } else {
          s[mt] = f32x4{0.f, 0.f, 0.f, 0.f};
        }
      }
#pragma unroll
      for (int ks = 0; ks < KS; ks++)
#pragma unroll
        for (int mt = 0; mt < 4; mt++) {
          bf16x8 kf = *(const bf16x8*)(sK + (16 * mt + r16) * LDK + c * DQK + ks * 32 + quad * 8);
          s[mt] = mfma16(kf, qf[c][ks], s[mt]);
          if (mt == 3) __builtin_amdgcn_sched_barrier(0);
        }
      __builtin_amdgcn_sched_barrier(0);
      if (diag) {
#pragma unroll
        for (int mt = 0; mt < 4; mt++)
#pragma unroll
          for (int i = 0; i < 4; i++)
            if (k0 + 16 * mt + 4 * quad + i > tq) s[mt][i] = -1e30f;
      }
      float mx = -1e30f;
#pragma unroll
      for (int mt = 0; mt < 4; mt++)
#pragma unroll
        for (int i = 0; i < 4; i++) mx = fmaxf(mx, s[mt][i]);
      mx = quadmax(mx);
      const float mnew = fmaxf(mrun[c], mx);
      const float alpha = fexp2(mrun[c] - mnew);
      mrun[c] = mnew;
      float ls = 0.f;
#pragma unroll
      for (int mt = 0; mt < 4; mt++)
#pragma unroll
        for (int i = 0; i < 4; i++) { s[mt][i] = fexp2(s[mt][i] - mnew); ls += s[mt][i]; }
      lrun[c] = lrun[c] * alpha + ls;
#pragma unroll
      for (int et = 0; et < 8; et++) oacc[c][et] *= alpha;
#pragma unroll
      for (int ks2 = 0; ks2 < 2; ks2++) {
        __builtin_amdgcn_sched_barrier(0);
        unsigned pk[4] = {pack2(s[2 * ks2][0], s[2 * ks2][1]), pack2(s[2 * ks2][2], s[2 * ks2][3]), pack2(s[2 * ks2 + 1][0], s[2 * ks2 + 1][1]),
                          pack2(s[2 * ks2 + 1][2], s[2 * ks2 + 1][3])};
        bf16x8 pf = __builtin_bit_cast(bf16x8, u32x4{pk[0], pk[1], pk[2], pk[3]});
#pragma unroll
        for (int et = 0; et < 8; et++) {
          const bf16_t* vp = sV + (16 * et + r16) * LDV + 32 * ks2 + 4 * quad;
          s16x4 lo = *(const s16x4*)vp, hi = *(const s16x4*)(vp + 16);
          bf16x8 vf = __builtin_shufflevector(lo, hi, 0, 1, 2, 3, 4, 5, 6, 7);
          oacc[c][et] = mfma16(vf, pf, oacc[c][et]);
          if (et == 3) __builtin_amdgcn_sched_barrier(0);
        }
      }
      __builtin_amdgcn_sched_barrier(0);
    }
  }
  float inv[NCOMP];
#pragma unroll
  for (int c = 0; c < NCOMP; c++) inv[c] = 1.f / quadsum(lrun[c]);
  f32x4 o[8];
  float ss = 0.f;
#pragma unroll
  for (int et = 0; et < 8; et++) {
#pragma unroll
    for (int i = 0; i < 4; i++) {
      float v = oacc[0][et][i] * inv[0];
      if (NCOMP == 2) v -= lam * oacc[NCOMP - 1][et][i] * inv[NCOMP - 1];
      o[et][i] = v;
      ss += v * v;
    }
  }
  float rs = 1.f;
  if (NORM) { ss = quadsum(ss); rs = rsqrtf(ss * (1.f / 128.f) + EPS) * outscale; }
#pragma unroll
  for (int et = 0; et < 8; et++) {
    const int e = 16 * et + 4 * quad;
    f32x4 ww = f32x4{1.f, 1.f, 1.f, 1.f};
    if (NORM) ww = *(const f32x4*)(normw + e);
    u32x2 ov = u32x2{pack2(o[et][0] * rs * ww.x, o[et][1] * rs * ww.y), pack2(o[et][2] * rs * ww.z, o[et][3] * rs * ww.w)};
    *(u32x2*)(O + (long)(16 * w + r16) * ldo + e) = ov;
  }
}

DI void gla_compute_b(const P& p, int h, long t0, float (&bl)[16], float& btot, float* sG, float* sTot) {
  const int tid = threadIdx.x, d = tid & 63, seg = tid >> 6;
  const float* glg = (const float*)(p.ws + OFF_GLG) + t0 * 16;
  ((f32x4*)sG)[tid] = ((const f32x4*)glg)[tid];
  float wg[16];
#pragma unroll
  for (int r = 0; r < 16; r++) wg[r] = p.gla_w_gate[r * 256 + h * 64 + d];
  const float bg = p.gla_b_gate[h * 64 + d];
  __syncthreads();
  float run = 0.f;
#pragma unroll
  for (int tt = 0; tt < 16; tt++) {
    const float* g = sG + (seg * 16 + tt) * 16;
    float z = bg;
#pragma unroll
    for (int r = 0; r < 16; r++) z += g[r] * wg[r];
    const float la = (fminf(z, 0.f) - log1pf(expf(-fabsf(z)))) * (1.f / 16.f);
    run += la;
    bl[tt] = run;
  }
  sTot[seg * 64 + d] = run;
  __syncthreads();
  float off = 0.f, tot = 0.f;
#pragma unroll
  for (int s2 = 0; s2 < 4; s2++) { const float v = sTot[s2 * 64 + d]; tot += v; if (s2 < seg) off += v; }
#pragma unroll
  for (int tt = 0; tt < 16; tt++) bl[tt] += off;
  btot = tot;
}
DI void gla_load_vT(const P& p, int h, long t0, bf16_t* sVT) {
  const int tid = threadIdx.x, e = tid & 127, half = tid >> 7;
  const bf16_t* gv = (const bf16_t*)(p.ws + OFF_GLV) + (t0 + half * 32) * 512 + h * 128 + e;
#pragma unroll
  for (int j = 0; j < 4; j++) {
    unsigned pk[4];
#pragma unroll
    for (int q = 0; q < 4; q++) {
      unsigned a = gv[(long)(j * 8 + 2 * q) * 512], b = gv[(long)(j * 8 + 2 * q + 1) * 512];
      pk[q] = a | (b << 16);
    }
    *(u32x4*)(sVT + e * LDT + half * 32 + j * 8) = u32x4{pk[0], pk[1], pk[2], pk[3]};
  }
}

DI void gla_local_item(const P& p, int item, char* smem) {
  const int tid = threadIdx.x, lane = tid & 63, w = tid >> 6, r16 = lane & 15, quad = lane >> 4;
  const int bh = item >> 7, c = item & 127, b = bh >> 2, h = bh & 3;
  const long t0 = (long)b * S_ + c * 64;
  bf16_t* sKT = (bf16_t*)smem;
  bf16_t* sVT = (bf16_t*)(smem + 9216);
  float* sG = (float*)(smem + 9216 + 18432);
  float* sTot = (float*)(smem + 9216 + 18432 + 4096);
  __syncthreads();
  float bl[16], btot;
  gla_compute_b(p, h, t0, bl, btot, sG, sTot);
  const int d = tid & 63, seg = tid >> 6;
  const bf16_t* gk = (const bf16_t*)(p.ws + OFF_GLK) + (t0 + seg * 16) * 256 + h * 64 + d;
  unsigned pk[8];
#pragma unroll
  for (int q = 0; q < 8; q++) {
    const float k0v = bf2f(gk[(long)(2 * q) * 256]) * __expf(btot - bl[2 * q]);
    const float k1v = bf2f(gk[(long)(2 * q + 1) * 256]) * __expf(btot - bl[2 * q + 1]);
    pk[q] = pack2(k0v, k1v);
  }
  *(u32x4*)(sKT + d * LDT + seg * 16) = u32x4{pk[0], pk[1], pk[2], pk[3]};
  *(u32x4*)(sKT + d * LDT + seg * 16 + 8) = u32x4{pk[4], pk[5], pk[6], pk[7]};
  if (seg == 0) ((float*)(p.ws + OFF_DEC))[(long)item * 64 + d] = __expf(btot);
  gla_load_vT(p, h, t0, sVT);
  __syncthreads();
  bf16_t* ST = (bf16_t*)((char*)p.out + OUT_ST) + (long)item * 8192;
#pragma unroll
  for (int n2 = 0; n2 < 2; n2++) {
    const int nt = 2 * w + n2;
    f32x4 acc[4];
#pragma unroll
    for (int mt = 0; mt < 4; mt++) acc[mt] = f32x4{0.f, 0.f, 0.f, 0.f};
#pragma unroll
    for (int ks = 0; ks < 2; ks++) {
      bf16x8 vf = *(const bf16x8*)(sVT + (16 * nt + r16) * LDT + ks * 32 + quad * 8);
#pragma unroll
      for (int mt = 0; mt < 4; mt++) {
        bf16x8 kf = *(const bf16x8*)(sKT + (16 * mt + r16) * LDT + ks * 32 + quad * 8);
        acc[mt] = mfma16(kf, vf, acc[mt]);
      }
    }
#pragma unroll
    for (int mt = 0; mt < 4; mt++) {
      u32x2 o = u32x2{pack2(acc[mt][0], acc[mt][1]), pack2(acc[mt][2], acc[mt][3])};
      *(u32x2*)(ST + (16 * nt + r16) * 64 + 16 * mt + 4 * quad) = o;
    }
  }
}

DI void gla_scan(const P& p) {
  const long gtid = (long)blockIdx.x * blockDim.x + threadIdx.x, gstride = (long)gridDim.x * blockDim.x;
  for (long g = gtid; g < 32 * 2048; g += gstride) {
    const int bh = (int)(g >> 11), eg = (int)(g & 2047), d = (eg * 4) & 63;
    bf16_t* ST = (bf16_t*)((char*)p.out + OUT_ST) + (long)bh * 128 * 8192 + eg * 4;
    const float* DEC = (const float*)(p.ws + OFF_DEC) + (long)bh * 128 * 64 + d;
    float st[4] = {0.f, 0.f, 0.f, 0.f};
#pragma unroll 4
    for (int c = 0; c < 128; c++) {
      const u32x2 loc = *(const u32x2*)(ST + (long)c * 8192);
      const f32x4 dec = *(const f32x4*)(DEC + c * 64);
      *(u32x2*)(ST + (long)c * 8192) = u32x2{pack2(st[0], st[1]), pack2(st[2], st[3])};
      st[0] = st[0] * dec.x + lo2f(loc.x);
      st[1] = st[1] * dec.y + hi2f(loc.x);
      st[2] = st[2] * dec.z + lo2f(loc.y);
      st[3] = st[3] * dec.w + hi2f(loc.y);
    }
  }
}

DI void gla_out_item(const P& p, int item, char* smem) {
  const int tid = threadIdx.x, lane = tid & 63, w = tid >> 6, r16 = lane & 15, quad = lane >> 4;
  const int bh = item >> 7, c = item & 127, b = bh >> 2, h = bh & 3;
  const long t0 = (long)b * S_ + c * 64;
  bf16_t* sQ = (bf16_t*)smem;
  bf16_t* sK = (bf16_t*)(smem + 9216);
  bf16_t* sVT = (bf16_t*)(smem + 18432);
  bf16_t* sST = (bf16_t*)(smem + 36864);
  float* sG = (float*)(smem + 36864);
  float* sTot = (float*)(smem + 36864 + 4096);
  __syncthreads();
  float bl[16], btot;
  gla_compute_b(p, h, t0, bl, btot, sG, sTot);
  const int d = tid & 63, seg = tid >> 6;
  const bf16_t* gq = (const bf16_t*)(p.ws + OFF_GLQ) + (t0 + seg * 16) * 256 + h * 64 + d;
  const bf16_t* gk = (const bf16_t*)(p.ws + OFF_GLK) + (t0 + seg * 16) * 256 + h * 64 + d;
#pragma unroll
  for (int tt = 0; tt < 16; tt++) {
    const float eb = __expf(bl[tt]);
    sQ[(seg * 16 + tt) * LDT + d] = f2bf(bf2f(gq[(long)tt * 256]) * eb);
    sK[(seg * 16 + tt) * LDT + d] = f2bf(bf2f(gk[(long)tt * 256]) / eb);
  }
  gla_load_vT(p, h, t0, sVT);
  __syncthreads();
  {
    const bf16_t* ST = (const bf16_t*)((const char*)p.out + OUT_ST) + (long)item * 8192;
#pragma unroll
    for (int i = 0; i < 4; i++) {
      const int cidx = tid + 256 * i, row = cidx >> 3, kc = (cidx & 7) * 8;
      *(u32x4*)(sST + row * LDT + kc) = *(const u32x4*)(ST + row * 64 + kc);
    }
  }
  __syncthreads();
  const int t = 16 * w + r16;
  bf16x8 qf[2];
#pragma unroll
  for (int ks = 0; ks < 2; ks++) qf[ks] = *(const bf16x8*)(sQ + t * LDT + ks * 32 + quad * 8);
  f32x4 a[4];
#pragma unroll
  for (int mt = 0; mt < 4; mt++) a[mt] = f32x4{0.f, 0.f, 0.f, 0.f};
#pragma unroll
  for (int ks = 0; ks < 2; ks++)
#pragma unroll
    for (int mt = 0; mt < 4; mt++) {
      bf16x8 kf = *(const bf16x8*)(sK + (16 * mt + r16) * LDT + ks * 32 + quad * 8);
      a[mt] = mfma16(kf, qf[ks], a[mt]);
    }
#pragma unroll
  for (int mt = 0; mt < 4; mt++)
#pragma unroll
    for (int i = 0; i < 4; i++)
      if (16 * mt + 4 * quad + i > t) a[mt][i] = 0.f;
  bf16x8 pf[2];
#pragma unroll
  for (int ks2 = 0; ks2 < 2; ks2++) {
    pf[ks2] = __builtin_bit_cast(bf16x8, u32x4{pack2(a[2 * ks2][0], a[2 * ks2][1]), pack2(a[2 * ks2][2], a[2 * ks2][3]),
                                               pack2(a[2 * ks2 + 1][0], a[2 * ks2 + 1][1]), pack2(a[2 * ks2 + 1][2], a[2 * ks2 + 1][3])});
  }
  f32x4 o[8];
  float ss = 0.f;
#pragma unroll
  for (int et = 0; et < 8; et++) {
    f32x4 acc = f32x4{0.f, 0.f, 0.f, 0.f};
#pragma unroll
    for (int ks = 0; ks < 2; ks++) {
      bf16x8 sf = *(const bf16x8*)(sST + (16 * et + r16) * LDT + ks * 32 + quad * 8);
      acc = mfma16(sf, qf[ks], acc);
    }
#pragma unroll
    for (int ks2 = 0; ks2 < 2; ks2++) {
      const bf16_t* vp = sVT + (16 * et + r16) * LDT + 32 * ks2 + 4 * quad;
      s16x4 lo = *(const s16x4*)vp, hi = *(const s16x4*)(vp + 16);
      bf16x8 vf = __builtin_shufflevector(lo, hi, 0, 1, 2, 3, 4, 5, 6, 7);
      acc = mfma16(vf, pf[ks2], acc);
    }
    o[et] = acc;
#pragma unroll
    for (int i = 0; i < 4; i++) ss += acc[i] * acc[i];
  }
  ss = quadsum(ss);
  const float rs = rsqrtf(ss * (1.f / 128.f) + EPS);
  bf16_t* R = (bf16_t*)(p.ws + OFF_GLR) + (t0 + t) * 512 + h * 128;
#pragma unroll
  for (int et = 0; et < 8; et++) {
    const int e = 16 * et + 4 * quad;
    const f32x4 ww = *(const f32x4*)(p.gla_out_norm_w + e);
    const u32x2 rr = *(const u32x2*)(R + e);
    const float r0 = lo2f(rr.x), r1 = hi2f(rr.x), r2 = lo2f(rr.y), r3 = hi2f(rr.y);
    const float y0 = o[et][0] * rs * ww.x * (r0 / (1.f + __expf(-r0)));
    const float y1 = o[et][1] * rs * ww.y * (r1 / (1.f + __expf(-r1)));
    const float y2 = o[et][2] * rs * ww.z * (r2 / (1.f + __expf(-r2)));
    const float y3 = o[et][3] * rs * ww.w * (r3 / (1.f + __expf(-r3)));
    *(u32x2*)(R + e) = u32x2{pack2(y0, y1), pack2(y2, y3)};
  }
}

constexpr int N_P2_ITEMS = 12288;
#ifndef P2_SUB
#define P2_SUB 7
#endif
#define P2S(n) (((P2_SUB) >> (n)) & 1)
DI void phase2_item(const P& p, int item, char* smem) {
  char* ws = p.ws;
  if (P2S(0) && item < 4096) {
    const int qb = 127 - (item >> 5), bh = item & 31, b = bh >> 2, h = bh & 3;
    const long trow = (long)b * S_ + qb * 64;
    const float slope = exp2f(-2.f * (float)(h + 1));
    const float lam = ((const float*)(ws + OFF_MISC))[0];
    bf16_t* Q = (bf16_t*)(ws + OFF_DAQ) + trow * 512 + h * 128;
    const bf16_t* Kp = (const bf16_t*)(ws + OFF_DAK) + (long)b * S_ * 512 + h * 128;
    const bf16_t* VT = (const bf16_t*)(ws + OFF_DAVT) + (long)(b * 4 + h) * 128 * S_;
    attn_item<64, 2, true, true>(Q, 512, Kp, 512, VT, S_, qb + 1, qb * 64, slope * LOG2E, lam, p.da_out_norm_w, 0.8f, Q, 512, (bf16_t*)smem,
                                 (bf16_t*)(smem + 64 * LDK * 2));
  } else if (P2S(1) && item < 8192) {
    const int it = item - 4096, qb = it >> 5, bh = it & 31, b = bh >> 2, h = bh & 3;
    const long trow = (long)b * S_ + qb * 64;
    bf16_t* Q = (bf16_t*)(ws + OFF_XAQ) + trow * 512 + h * 128;
    const bf16_t* Kp = (const bf16_t*)(ws + OFF_MK) + (long)b * 256 * 512 + h * 128;
    const bf16_t* VT = (const bf16_t*)(ws + OFF_MVT) + (long)(b * 4 + h) * 128 * 256;
    attn_item<128, 1, false, false>(Q, 512, Kp, 512, VT, 256, 4, 0, 0.f, 0.f, nullptr, 1.f, Q, 512, (bf16_t*)smem, (bf16_t*)(smem + 64 * LDK * 2));
  } else if (P2S(2)) {
    gla_local_item(p, item - 8192, smem);
  }
}

DI void phase5_tile(const P& p, int tile, bf16_t* sA, bf16_t* sB, u32x2* sM) {
  const int tid = threadIdx.x, lane = tid & 63, w = tid >> 6, r16 = lane & 15, quad = lane >> 4;
  char* ws = p.ws;
  const int xcd = tile & 7, j = tile >> 3, mp = (j >> 3) * 8 + xcd, nt_ = j & 7;
  const long m0 = (long)mp * 128;
  bf16_t* dst = (bf16_t*)(ws + OFF_MERGED) + m0 * 1024 + nt_ * 128;
#pragma unroll 1
  for (int br = 0; br < 3; br++) {
    u32x2 ob[2][8];
    {
      f32x4 acc[2][8];
      zero_acc(acc);
      const size_t oo = br == 0 ? OFF_DAQ : (br == 1 ? OFF_GLR : OFF_XAQ);
      gemm_tile<false>((const bf16_t*)(ws + oo) + m0 * 512, 512, (const bf16_t*)(ws + OFF_WBR + br * MiB) + (long)nt_ * 128 * 512, 512, 512, acc, sA, sB);
#pragma unroll
      for (int mt = 0; mt < 2; mt++)
#pragma unroll
        for (int nt = 0; nt < 8; nt++) ob[mt][nt] = u32x2{pack2(acc[mt][nt][0], acc[mt][nt][1]), pack2(acc[mt][nt][2], acc[mt][nt][3])};
    }
    __builtin_amdgcn_sched_barrier(0);
    f32x4 acc[2][8];
    zero_acc(acc);
    gemm_tile<false>((const bf16_t*)((const char*)p.out + OUT_XN) + m0 * 1024, 1024, (const bf16_t*)(ws + OFF_WG) + (long)(br * 1024 + nt_ * 128) * 1024, 1024, 1024,
              acc, sA, sB);
    __builtin_amdgcn_sched_barrier(0);
#pragma unroll
    for (int mt = 0; mt < 2; mt++) {
      const int m = 32 * w + 16 * mt + r16;
#pragma unroll
      for (int nt = 0; nt < 8; nt++) {
        u32x2 mg = u32x2{0u, 0u};
        if (br > 0) mg = sM[(mt * 8 + nt) * 256 + tid];
        const float v0 = lo2f(mg.x) + lo2f(ob[mt][nt].x) * frcp(1.f + __expf(-acc[mt][nt][0]));
        const float v1 = hi2f(mg.x) + hi2f(ob[mt][nt].x) * frcp(1.f + __expf(-acc[mt][nt][1]));
        const float v2 = lo2f(mg.y) + lo2f(ob[mt][nt].y) * frcp(1.f + __expf(-acc[mt][nt][2]));
        const float v3 = hi2f(mg.y) + hi2f(ob[mt][nt].y) * frcp(1.f + __expf(-acc[mt][nt][3]));
        const u32x2 r = u32x2{pack2(v0, v1), pack2(v2, v3)};
        if (br < 2) sM[(mt * 8 + nt) * 256 + tid] = r;
        else *(u32x2*)(dst + (long)m * 1024 + 16 * nt + 4 * quad) = r;
        __builtin_amdgcn_sched_barrier(0);
      }
    }
  }
}
DI void phase6_tile(const P& p, int tile, bf16_t* sA, bf16_t* sB) {
  const int tid = threadIdx.x, lane = tid & 63, w = tid >> 6, r16 = lane & 15, quad = lane >> 4;
  char* ws = p.ws;
  const int xcd = tile & 7, j = tile >> 3, mp = (j >> 3) * 8 + xcd, nt_ = j & 7;
  const long m0 = (long)mp * 128;
  f32x4 acc[2][8];
  zero_acc(acc);
  gemm_tile((const bf16_t*)(ws + OFF_MERGED) + m0 * 1024, 1024, (const bf16_t*)(ws + OFF_WOUT) + (long)nt_ * 128 * 1024, 1024, 1024, acc, sA, sB);
#pragma unroll
  for (int mt = 0; mt < 2; mt++) {
    const long m = m0 + 32 * w + 16 * mt + r16;
#pragma unroll
    for (int nt = 0; nt < 8; nt++) {
      const int col = nt_ * 128 + 16 * nt + 4 * quad;
      const f32x4 xv = *(const f32x4*)(p.x + m * 1024 + col);
      *(f32x4*)(p.out + m * 1024 + col) = f32x4{xv.x + acc[mt][nt][0], xv.y + acc[mt][nt][1], xv.z + acc[mt][nt][2], xv.w + acc[mt][nt][3]};
    }
  }
}

constexpr int LDSK = 136;
DI void peer_topk_item(const P& p, int item, char* smem) {
  const int tid = threadIdx.x, lane = tid & 63, w = tid >> 6, r16 = lane & 15, quad = lane >> 4;
  char* ws = p.ws;
  const int xcd = item & 7, j = item >> 3, mp = (j >> 3) * 8 + xcd, h = j & 7;
  const long m0 = (long)mp * 128;
  bf16_t* sA = (bf16_t*)smem;
  bf16_t* sB = (bf16_t*)(smem + 128 * LDT * 2);
  bf16_t* sSK = (bf16_t*)smem;
  float* sTopV = (float*)(smem + 36864);
  int* sTopI = (int*)(smem + 36864 + 16384);
#pragma unroll 1
  for (int pp = 0; pp < 2; pp++) {
    f32x4 acc[2][8];
    zero_acc(acc);
    gemm_tile((const bf16_t*)(ws + OFF_XN2) + m0 * 1024, 1024, (const bf16_t*)(ws + OFF_WQ) + (long)(h * 256 + pp * 128) * 1024, 1024, 1024, acc, sA, sB);
    bf16x8 qf[2][4];
#pragma unroll
    for (int mt = 0; mt < 2; mt++)
#pragma unroll
      for (int ks = 0; ks < 4; ks++)
        qf[mt][ks] = __builtin_bit_cast(bf16x8, u32x4{pack2(acc[mt][2 * ks][0], acc[mt][2 * ks][1]), pack2(acc[mt][2 * ks][2], acc[mt][2 * ks][3]),
                                                       pack2(acc[mt][2 * ks + 1][0], acc[mt][2 * ks + 1][1]), pack2(acc[mt][2 * ks + 1][2], acc[mt][2 * ks + 1][3])});
    __builtin_amdgcn_sched_barrier(0);
    __syncthreads();
    {
      const bf16_t* SK = (const bf16_t*)(ws + OFF_SUBK) + pp * 128 * 128;
#pragma unroll
      for (int i = 0; i < 8; i++) {
        const int cidx = tid + 256 * i, row = cidx >> 4, kc = (cidx & 15) * 8;
        *(u32x4*)(sSK + row * LDSK + kc) = *(const u32x4*)(SK + row * 128 + kc);
      }
    }
    __syncthreads();
#pragma unroll
    for (int mt = 0; mt < 2; mt++) {
      f32x4 sc[8];
#pragma unroll
      for (int nt = 0; nt < 8; nt++) sc[nt] = f32x4{0.f, 0.f, 0.f, 0.f};
#pragma unroll
      for (int ks = 0; ks < 4; ks++) {
#pragma unroll
        for (int nt = 0; nt < 8; nt++) {
          const bf16_t* kp = sSK + (16 * nt + r16) * LDSK + 32 * ks + 4 * quad;
          s16x4 lo = *(const s16x4*)kp, hi = *(const s16x4*)(kp + 16);
          bf16x8 kf = __builtin_shufflevector(lo, hi, 0, 1, 2, 3, 4, 5, 6, 7);
          sc[nt] = mfma16(kf, qf[mt][ks], sc[nt]);
        }
        __builtin_amdgcn_sched_barrier(0);
      }
      const int tok = 32 * w + 16 * mt + r16;
#pragma unroll 1
      for (int r = 0; r < 16; r++) {
        float bv = -INFINITY;
        int bi = 0;
#pragma unroll
        for (int nt = 0; nt < 8; nt++)
#pragma unroll
          for (int i = 0; i < 4; i++) {
            const float v = sc[nt][i];
            if (v > bv) { bv = v; bi = 16 * nt + i; }
          }
        bi += 4 * quad;
#pragma unroll
        for (int off = 16; off <= 32; off <<= 1) {
          const float ov = __shfl_xor(bv, off);
          const int oi = __shfl_xor(bi, off);
          if (ov > bv || (ov == bv && oi < bi)) { bv = ov; bi = oi; }
        }
        if (quad == 0) { sTopV[(pp * 128 + tok) * 16 + r] = bv; sTopI[(pp * 128 + tok) * 16 + r] = bi; }
        const int loc = bi - 4 * quad;
#pragma unroll
        for (int nt = 0; nt < 8; nt++)
#pragma unroll
          for (int i = 0; i < 4; i++)
            if (loc == 16 * nt + i) sc[nt][i] = -INFINITY;
      }
      __builtin_amdgcn_sched_barrier(0);
    }
  }
  __syncthreads();
  if (tid < 128) {
    const int tok = tid;
    float a[16], b[16];
#pragma unroll
    for (int i = 0; i < 16; i++) { a[i] = sTopV[tok * 16 + i]; b[i] = sTopV[(128 + tok) * 16 + i]; }
    float cand[50];
    {
      int q = 0;
#pragma unroll
      for (int i = 0; i < 16; i++)
#pragma unroll
        for (int jj = 0; jj < 16; jj++)
          if ((i + 1) * (jj + 1) <= 16) { cand[q] = a[i] + b[jj]; q++; }
    }
    int* PIDX = (int*)(ws + OFF_PIDX) + ((m0 + tok) * 8 + h) * 16;
    float* PG = (float*)(ws + OFF_PG) + ((m0 + tok) * 8 + h) * 16;
    float top0 = 0.f, gsum = 0.f;
#pragma unroll 1
    for (int r = 0; r < 16; r++) {
      float bv = -INFINITY;
      int bc = 0;
      {
        int q = 0;
#pragma unroll
        for (int i = 0; i < 16; i++)
#pragma unroll
          for (int jj = 0; jj < 16; jj++)
            if ((i + 1) * (jj + 1) <= 16) { if (cand[q] > bv) { bv = cand[q]; bc = i * 16 + jj; } q++; }
      }
      {
        int q = 0;
#pragma unroll
        for (int i = 0; i < 16; i++)
#pragma unroll
          for (int jj = 0; jj < 16; jj++)
            if ((i + 1) * (jj + 1) <= 16) { if (bc == i * 16 + jj) cand[q] = -INFINITY; q++; }
      }
      if (r == 0) top0 = bv;
      const float e = __expf(bv - top0);
      gsum += e;
      PIDX[r] = sTopI[tok * 16 + (bc >> 4)] * 128 + sTopI[(128 + tok) * 16 + (bc & 15)];
      PG[r] = e;
    }
    const float ginv = 1.f / gsum;
#pragma unroll 1
    for (int r = 0; r < 16; r++) PG[r] *= ginv;
  }
}

DI float dot8(u32x4 u, const float* xf) {
  float s = lo2f(u.x) * xf[0];
  s += hi2f(u.x) * xf[1];
  s += lo2f(u.y) * xf[2];
  s += hi2f(u.y) * xf[3];
  s += lo2f(u.z) * xf[4];
  s += hi2f(u.z) * xf[5];
  s += lo2f(u.w) * xf[6];
  s += hi2f(u.w) * xf[7];
  return s;
}
DI void fma8(float* o, u32x4 v, float c) {
  o[0] += c * lo2f(v.x); o[1] += c * hi2f(v.x); o[2] += c * lo2f(v.y); o[3] += c * hi2f(v.y);
  o[4] += c * lo2f(v.z); o[5] += c * hi2f(v.z); o[6] += c * lo2f(v.w); o[7] += c * hi2f(v.w);
}
DI void peer_eval(const P& p) {
  const int lane = threadIdx.x & 63;
  const int gwave = blockIdx.x * 4 + (threadIdx.x >> 6), nwaves = gridDim.x * 4;
  const bf16_t* U = (const bf16_t*)(p.ws + OFF_U);
  const bf16_t* V = (const bf16_t*)(p.ws + OFF_V);
  const int myk = (lane >> 2) & 15;
  for (int t = gwave; t < T_; t += nwaves) {
    const u32x4* xr = (const u32x4*)((const bf16_t*)(p.ws + OFF_XN2) + (long)t * 1024);
    const u32x4 x0 = xr[lane], x1 = xr[64 + lane];
    float xf[16];
    xf[0] = lo2f(x0.x); xf[1] = hi2f(x0.x); xf[2] = lo2f(x0.y); xf[3] = hi2f(x0.y); xf[4] = lo2f(x0.z); xf[5] = hi2f(x0.z); xf[6] = lo2f(x0.w); xf[7] = hi2f(x0.w);
    xf[8] = lo2f(x1.x); xf[9] = hi2f(x1.x); xf[10] = lo2f(x1.y); xf[11] = hi2f(x1.y); xf[12] = lo2f(x1.z); xf[13] = hi2f(x1.z); xf[14] = lo2f(x1.w); xf[15] = hi2f(x1.w);
    float o[16];
#pragma unroll
    for (int i = 0; i < 16; i++) o[i] = 0.f;
#pragma unroll 1
    for (int h = 0; h < 8; h++) {
      const int eidx = ((const int*)(p.ws + OFF_PIDX))[((long)t * 8 + h) * 16 + myk];
      const float g = ((const float*)(p.ws + OFF_PG))[((long)t * 8 + h) * 16 + myk];
      float part[16];
#pragma unroll
      for (int k = 0; k < 16; k++) {
        const int e = __builtin_amdgcn_readlane(eidx, 4 * k);
        const u32x4* ur = (const u32x4*)(U + (long)e * 1024);
        const u32x4 u0 = ur[lane], u1 = ur[64 + lane];
        part[k] = dot8(u0, xf) + dot8(u1, xf + 8);
      }
      float p8[8], p4[4], p2[2], p1;
      {
        const bool hb = (lane & 32) != 0;
#pragma unroll
        for (int k = 0; k < 8; k++) { const float keep = hb ? part[k + 8] : part[k], send = hb ? part[k] : part[k + 8]; p8[k] = keep + __shfl_xor(send, 32); }
      }
      {
        const bool hb = (lane & 16) != 0;
#pragma unroll
        for (int k = 0; k < 4; k++) { const float keep = hb ? p8[k + 4] : p8[k], send = hb ? p8[k] : p8[k + 4]; p4[k] = keep + __shfl_xor(send, 16); }
      }
      {
        const bool hb = (lane & 8) != 0;
#pragma unroll
        for (int k = 0; k < 2; k++) { const float keep = hb ? p4[k + 2] : p4[k], send = hb ? p4[k] : p4[k + 2]; p2[k] = keep + __shfl_xor(send, 8); }
      }
      {
        const bool hb = (lane & 4) != 0;
        const float keep = hb ? p2[1] : p2[0], send = hb ? p2[0] : p2[1];
        p1 = keep + __shfl_xor(send, 4);
      }
      p1 += __shfl_xor(p1, 1);
      p1 += __shfl_xor(p1, 2);
      const float act = 0.5f * p1 * (1.f + erff(p1 * 0.70710678118654752f));
      const float coef = g * act;
#pragma unroll
      for (int k = 0; k < 16; k++) {
        const int e = __builtin_amdgcn_readlane(eidx, 4 * k);
        const float cf = __int_as_float(__builtin_amdgcn_readlane(__float_as_int(coef), 4 * k));
        const u32x4* vr = (const u32x4*)(V + (long)e * 1024);
        const u32x4 v0 = vr[lane], v1 = vr[64 + lane];
        fma8(o, v0, cf);
        fma8(o + 8, v1, cf);
      }
    }
    float* orow = p.out + (long)t * 1024;
    f32x4 a0 = *(f32x4*)(orow + 8 * lane), a1 = *(f32x4*)(orow + 8 * lane + 4), b0 = *(f32x4*)(orow + 512 + 8 * lane), b1 = *(f32x4*)(orow + 512 + 8 * lane + 4);
    *(f32x4*)(orow + 8 * lane) = f32x4{a0.x + o[0], a0.y + o[1], a0.z + o[2], a0.w + o[3]};
    *(f32x4*)(orow + 8 * lane + 4) = f32x4{a1.x + o[4], a1.y + o[5], a1.z + o[6], a1.w + o[7]};
    *(f32x4*)(orow + 512 + 8 * lane) = f32x4{b0.x + o[8], b0.y + o[9], b0.z + o[10], b0.w + o[11]};
    *(f32x4*)(orow + 512 + 8 * lane + 4) = f32x4{b1.x + o[12], b1.y + o[13], b1.z + o[14], b1.w + o[15]};
  }
}

#ifndef PH_MASK
#define PH_MASK 0x3ff
#endif
#define PH_ON(n) (((PH_MASK) >> (n)) & 1)
constexpr int SMEM_BYTES = 69632;
__global__ void __launch_bounds__(256, 2) mega(P p) {
  __shared__ __attribute__((aligned(16))) char smem[SMEM_BYTES];
  __shared__ int s_item;
  cg::grid_group grid = cg::this_grid();
  bf16_t* sA = (bf16_t*)smem;
  bf16_t* sB = (bf16_t*)(smem + 128 * LDT * 2);
  const int lo = p.phase_lo, hi = p.phase_hi;
#define PH_RUN(n) (PH_ON(n) && lo <= (n) && (n) <= hi)
#define PH_SYNC(n) if (lo <= (n) && (n) < hi) grid.sync();
  if (PH_RUN(0)) phase0(p);
  PH_SYNC(0)
  if (PH_RUN(1)) {
    for (int t = blockIdx.x; t < N_INPROJ_TILES + N_MEMKV_TILES; t += gridDim.x) phase1_tile(p, t, sA, sB);
  }
  PH_SYNC(1)
  if (PH_RUN(2)) {
    unsigned* ctr = (unsigned*)(p.ws + OFF_MISC) + 16;
    while (true) {
      __syncthreads();
      if (threadIdx.x == 0) s_item = (int)atomicAdd(ctr, 1u);
      __syncthreads();
      const int item = s_item;
      if (item >= N_P2_ITEMS) break;
      phase2_item(p, item, smem);
    }
  }
  PH_SYNC(2)
  if (PH_RUN(3)) gla_scan(p);
  PH_SYNC(3)
  if (PH_RUN(4)) {
    for (int it = blockIdx.x; it < 4096; it += gridDim.x) gla_out_item(p, it, smem);
  }
  PH_SYNC(4)
  if (PH_RUN(5)) {
    for (int t = blockIdx.x; t < 4096; t += gridDim.x) phase5_tile(p, t, sA, sB, (u32x2*)(smem + 36864));
  }
  PH_SYNC(5)
  if (PH_RUN(6)) {
    for (int t = blockIdx.x; t < 4096; t += gridDim.x) phase6_tile(p, t, sA, sB);
  }
  PH_SYNC(6)
  if (PH_RUN(7)) {
    const long gtid = (long)blockIdx.x * blockDim.x + threadIdx.x, gstride = (long)gridDim.x * blockDim.x;
    rmsnorm_rows(p.out, p.ffn_norm_w, (bf16_t*)(p.ws + OFF_XN2), T_, (int)(gtid >> 6), (int)(gstride >> 6));
  }
  PH_SYNC(7)
  if (PH_RUN(8)) {
    for (int it = blockIdx.x; it < 4096; it += gridDim.x) peer_topk_item(p, it, smem);
  }
  PH_SYNC(8)
  if (PH_RUN(9)) peer_eval(p);
}

extern "C" void kernel_launch(void* const* d_in, const int* in_sizes, int n_in, void* d_out, int out_size, void* d_ws, size_t ws_size, hipStream_t stream) {
  static int grid_blocks = 0;
  if (!grid_blocks) {
    int dev = 0, cus = 0, per_cu = 0;
    hipGetDevice(&dev);
    hipDeviceGetAttribute(&cus, hipDeviceAttributeMultiprocessorCount, dev);
    hipOccupancyMaxActiveBlocksPerMultiprocessor(&per_cu, mega, 256, 0);
    if (per_cu < 1) per_cu = 1;
    if (per_cu > 2) per_cu = 2;
    grid_blocks = cus * per_cu;
  }
  P p{};
  const float** f = (const float**)&p;
  for (int i = 0; i < 24; i++) f[i] = (const float*)d_in[i];
  p.out = (float*)d_out;
  p.ws = (char*)d_ws;
  p.phase_lo = 0;
  p.phase_hi = 9;
  void* args[] = {&p};
  hipError_t e = hipLaunchCooperativeKernel((void*)mega, dim3(grid_blocks), dim3(256), args, 0, stream);
  if (e != hipSuccess) fprintf(stderr, "cooperative launch failed: %s (grid %d)\n", hipGetErrorString(e), grid_blocks);
}
```

```cpp
#include <hip/hip_runtime.h>
#include <hip/hip_cooperative_groups.h>
#include <cstdio>
namespace cg = cooperative_groups;

#define DI __device__ __forceinline__
typedef unsigned short bf16_t;
typedef short bf16x8 __attribute__((ext_vector_type(8)));
typedef short s16x4 __attribute__((ext_vector_type(4)));
typedef float f32x4 __attribute__((ext_vector_type(4)));
typedef unsigned u32x4 __attribute__((ext_vector_type(4)));
typedef unsigned u32x2 __attribute__((ext_vector_type(2)));
typedef __bf16 bf2_t __attribute__((ext_vector_type(2)));

constexpr int T_ = 65536, S_ = 8192;
constexpr float EPS = 1e-6f;
constexpr float LOG2E = 1.4426950408889634f;
constexpr size_t MiB = 1ull << 20;
constexpr size_t OFF_WIN = 0, OFF_WG = 8 * MiB, OFF_WMEM = 14 * MiB, OFF_WBR = 16 * MiB, OFF_WOUT = 20 * MiB, OFF_WQ = 22 * MiB,
                 OFF_SUBK = 26 * MiB, OFF_MISC = 27 * MiB, OFF_MEMN = 28 * MiB, OFF_MK = 32 * MiB, OFF_MVT = 34 * MiB, OFF_GLG = 36 * MiB,
                 OFF_DEC = 40 * MiB, OFF_U = 48 * MiB, OFF_V = 80 * MiB, OFF_DAQ = 112 * MiB, OFF_DAK = 176 * MiB, OFF_DAVT = 240 * MiB,
                 OFF_GLQ = 304 * MiB, OFF_GLK = 336 * MiB, OFF_GLV = 368 * MiB, OFF_GLR = 432 * MiB, OFF_XAQ = 496 * MiB, OFF_MERGED = 560 * MiB;
constexpr size_t OFF_ROWSS = OFF_MISC + 512 * 1024;
constexpr size_t OFF_SU = OFF_MISC + 128 * 1024, OFF_SV = OFF_MISC + 256 * 1024;
constexpr size_t OFF_XN2 = OFF_DAK, OFF_PIDX = OFF_GLQ, OFF_PG = OFF_GLK;
constexpr size_t OUT_XN = 0, OUT_ST = 128 * MiB;

struct P {
  const float *x, *mem, *mix_norm_w, *w_in, *da_q_norm_w, *da_k_norm_w, *da_lambda, *da_out_norm_w, *gla_w_gate, *gla_b_gate,
      *gla_out_norm_w, *mem_norm_w, *w_mem_kv, *xa_q_norm_w, *xa_k_norm_w, *w_br_da, *w_br_gla, *w_br_xa, *w_out, *ffn_norm_w,
      *peer_w_q, *peer_sub_keys, *peer_u, *peer_v;
  float* out;
  char* ws;
  int phase_lo, phase_hi;
};

DI bf16_t f2bf(float f) { unsigned u = __float_as_uint(f); u += 0x7fffu + ((u >> 16) & 1u); return (bf16_t)(u >> 16); }
DI float bf2f(bf16_t h) { return __uint_as_float(((unsigned)h) << 16); }
typedef float f32x2_ __attribute__((ext_vector_type(2)));
typedef __bf16 bf16x2_ __attribute__((ext_vector_type(2)));
DI unsigned pack2(float a, float b) { return __builtin_bit_cast(unsigned, __builtin_convertvector(f32x2_{a, b}, bf16x2_)); }
DI bf16x8 pack8_mfma(float a0, float a1, float a2, float a3, float a4, float a5, float a6, float a7) {
  return __builtin_bit_cast(bf16x8, u32x4{pack2(a0, a1), pack2(a2, a3), pack2(a4, a5), pack2(a6, a7)});
}
DI float lo2f(unsigned u) { return __uint_as_float(u << 16); }
DI float hi2f(unsigned u) { return __uint_as_float(u & 0xffff0000u); }
DI f32x4 mfma16(bf16x8 a, bf16x8 b, f32x4 c) { return __builtin_amdgcn_mfma_f32_16x16x32_bf16(a, b, c, 0, 0, 0); }
DI float fexp2(float x) { return __builtin_amdgcn_exp2f(x); }
DI float frcp(float x) { return __builtin_amdgcn_rcpf(x); }
DI void glds16(const void* g, unsigned lds_base) {
  unsigned sv;
  asm volatile("s_mov_b32 %0, m0\n\ts_mov_b32 m0, %2\n\ts_nop 0\n\tglobal_load_lds_dwordx4 %1, off\n\ts_mov_b32 m0, %0" : "=&s"(sv) : "v"(g), "s"(lds_base) : "memory");
}
DI unsigned lds_addr(const void* p) { return (unsigned)(size_t)p; }
DI float xor16(float v) { return __shfl_xor(v, 16); }
DI float xor32(float v) { return __shfl_xor(v, 32); }
DI float quadsum(float v) { v += __shfl_xor(v, 16); v += __shfl_xor(v, 32); return v; }
DI float quadmax(float v) { v = fmaxf(v, __shfl_xor(v, 16)); v = fmaxf(v, __shfl_xor(v, 32)); return v; }
DI float wavesum(float v) {
#pragma unroll
  for (int o = 32; o > 0; o >>= 1) v += __shfl_xor(v, o);
  return v;
}

constexpr int LDT = 72;
#define RAW_BARRIER() do { asm volatile("s_waitcnt lgkmcnt(0)" ::: "memory"); __builtin_amdgcn_s_barrier(); } while (0)
template <int BK, int STAGES>
DI void gemm_tile(const bf16_t* __restrict__ A, long lda, const bf16_t* __restrict__ Bt, long ldb, int K, f32x4 (&acc)[2][8], char* sbuf) {
  const int tid = threadIdx.x, lane = tid & 63, w = tid >> 6, r16 = lane & 15, quad = lane >> 4;
  const int wu = __builtin_amdgcn_readfirstlane(w);
  constexpr int CH = BK / 8, RPI = 64 / CH, NI = 128 / RPI / 4, TILE_B = 128 * BK * 2, STAGE_B = 2 * TILE_B;
  auto issue = [&](int kt_, int st) {
#pragma unroll
    for (int i = 0; i < NI; i++) {
      const int j = wu + 4 * i;
      const int row = RPI * j + lane / CH, pp = lane % CH;
      const int c = pp ^ (BK == 32 ? ((row >> 2) & 3) : ((row >> 1) & 7));
      glds16(A + (long)row * lda + kt_ * BK + c * 8, __builtin_amdgcn_readfirstlane(lds_addr(sbuf + st * STAGE_B + j * 1024)));
      glds16(Bt + (long)row * ldb + kt_ * BK + c * 8, __builtin_amdgcn_readfirstlane(lds_addr(sbuf + st * STAGE_B + TILE_B + j * 1024)));
    }
  };
  const int nk = K / BK;
  __syncthreads();
#pragma unroll
  for (int s_ = 0; s_ < STAGES - 1; s_++) issue(s_, s_);
  const int swz = BK == 32 ? ((r16 >> 2) & 3) : ((r16 >> 1) & 7);
#pragma unroll 1
  for (int kt = 0; kt < nk; kt++) {
    if (STAGES == 2 || kt + STAGES - 2 >= nk) {
      asm volatile("s_waitcnt vmcnt(0)" ::: "memory");
    } else {
      if (NI == 2) asm volatile("s_waitcnt vmcnt(4)" ::: "memory");
      else asm volatile("s_waitcnt vmcnt(8)" ::: "memory");
    }
    RAW_BARRIER();
    if (kt + STAGES - 1 < nk) issue(kt + STAGES - 1, (kt + STAGES - 1) % STAGES);
    const bf16_t* sA = (const bf16_t*)(sbuf + (kt % STAGES) * STAGE_B);
    const bf16_t* sB = (const bf16_t*)(sbuf + (kt % STAGES) * STAGE_B + TILE_B);
#pragma unroll
    for (int ks = 0; ks < BK / 32; ks++) {
      bf16x8 af[2];
#pragma unroll
      for (int mt = 0; mt < 2; mt++) af[mt] = *(const bf16x8*)(sA + (32 * w + 16 * mt + r16) * BK + (((ks * 4 + quad) ^ swz) * 8));
#pragma unroll
      for (int nt = 0; nt < 8; nt++) {
        bf16x8 bfr = *(const bf16x8*)(sB + (16 * nt + r16) * BK + (((ks * 4 + quad) ^ swz) * 8));
#pragma unroll
        for (int mt = 0; mt < 2; mt++) acc[mt][nt] = mfma16(bfr, af[mt], acc[mt][nt]);
      }
    }
  }
}
DI void zero_acc(f32x4 (&acc)[2][8]) {
#pragma unroll
  for (int a = 0; a < 2; a++)
#pragma unroll
    for (int b = 0; b < 8; b++) acc[a][b] = f32x4{0.f, 0.f, 0.f, 0.f};
}

DI void transpose_convert(const float* __restrict__ src, int ldsrc, int col0, bf16_t* __restrict__ dst, int K, int n0, int ncols, long gtid, long gstride) {
  const long total = (long)ncols * (K / 8);
  for (long idx = gtid; idx < total; idx += gstride) {
    const int n = (int)(idx % ncols), kc = (int)(idx / ncols);
    unsigned pk[4];
#pragma unroll
    for (int j = 0; j < 4; j++) {
      float a = src[(long)(kc * 8 + 2 * j) * ldsrc + col0 + n];
      float b = src[(long)(kc * 8 + 2 * j + 1) * ldsrc + col0 + n];
      pk[j] = pack2(a, b);
    }
    *(u32x4*)(dst + (long)(n0 + n) * K + kc * 8) = u32x4{pk[0], pk[1], pk[2], pk[3]};
  }
}
DI void convert_flat(const float* __restrict__ src, bf16_t* __restrict__ dst, long n, long gtid, long gstride) {
  for (long i = gtid; i < n / 8; i += gstride) {
    f32x4 a = ((const f32x4*)src)[2 * i], b = ((const f32x4*)src)[2 * i + 1];
    ((u32x4*)dst)[i] = u32x4{pack2(a.x, a.y), pack2(a.z, a.w), pack2(b.x, b.y), pack2(b.z, b.w)};
  }
}
DI void rmsnorm_rows(const float* __restrict__ src, const float* __restrict__ w, bf16_t* __restrict__ dst, int nrows, int gwave, int nwaves) {
  const int lane = threadIdx.x & 63;
  for (int r = gwave; r < nrows; r += nwaves) {
    const f32x4* s4 = (const f32x4*)(src + (long)r * 1024);
    f32x4 v[4];
    float ss = 0.f;
#pragma unroll
    for (int j = 0; j < 4; j++) { v[j] = s4[j * 64 + lane]; ss += v[j].x * v[j].x + v[j].y * v[j].y + v[j].z * v[j].z + v[j].w * v[j].w; }
    ss = wavesum(ss);
    const float rstd = rsqrtf(ss * (1.f / 1024.f) + EPS);
#pragma unroll
    for (int j = 0; j < 4; j++) {
      f32x4 ww = ((const f32x4*)w)[j * 64 + lane];
      u32x2 o = u32x2{pack2(v[j].x * rstd * ww.x, v[j].y * rstd * ww.y), pack2(v[j].z * rstd * ww.z, v[j].w * rstd * ww.w)};
      *(u32x2*)(dst + (long)r * 1024 + (j * 64 + lane) * 4) = o;
    }
  }
}

DI void quant_rows_fp8(const float* __restrict__ src, unsigned* __restrict__ dst, float* __restrict__ scales, int nrows, int gwave, int nwaves) {
  const int lane = threadIdx.x & 63;
  for (int r = gwave; r < nrows; r += nwaves) {
    const f32x4* s4 = (const f32x4*)(src + (long)r * 1024 + lane * 16);
    f32x4 v[4];
    float am = 0.f;
#pragma unroll
    for (int j = 0; j < 4; j++) {
      v[j] = s4[j];
      am = fmaxf(am, fmaxf(fmaxf(fabsf(v[j].x), fabsf(v[j].y)), fmaxf(fabsf(v[j].z), fabsf(v[j].w))));
    }
#pragma unroll
    for (int o = 32; o > 0; o >>= 1) am = fmaxf(am, __shfl_xor(am, o));
    const float sc = am > 0.f ? am * (1.f / 448.f) : 1.f;
    const float inv = 1.f / sc;
    u32x4 o4;
#pragma unroll
    for (int j = 0; j < 4; j++) {
      int w_ = __builtin_amdgcn_cvt_pk_fp8_f32(v[j].x * inv, v[j].y * inv, 0, false);
      w_ = __builtin_amdgcn_cvt_pk_fp8_f32(v[j].z * inv, v[j].w * inv, w_, true);
      o4[j] = (unsigned)w_;
    }
    *(u32x4*)(dst + (long)r * 256 + lane * 4) = o4;
    if (lane == 0) scales[r] = sc;
  }
}

DI void phase0(const P& p) {
  const long gtid = (long)blockIdx.x * blockDim.x + threadIdx.x, gstride = (long)gridDim.x * blockDim.x;
  char* ws = p.ws;
  bf16_t* win = (bf16_t*)(ws + OFF_WIN);
  transpose_convert(p.w_in, 6672, 0, win, 1024, 0, 3072, gtid, gstride);
  transpose_convert(p.w_in, 6672, 3088, win, 1024, 3072, 512, gtid, gstride);
  transpose_convert(p.w_in, 6672, 3072, win, 1024, 3584, 16, gtid, gstride);
  for (long i = gtid; i < 112 * 1024 / 8; i += gstride) ((u32x4*)(win + 3600 * 1024))[i] = u32x4{0, 0, 0, 0};
  transpose_convert(p.w_in, 6672, 3600, (bf16_t*)(ws + OFF_WG), 1024, 0, 3072, gtid, gstride);
  transpose_convert(p.w_mem_kv, 1024, 0, (bf16_t*)(ws + OFF_WMEM), 1024, 0, 1024, gtid, gstride);
  transpose_convert(p.w_br_da, 1024, 0, (bf16_t*)(ws + OFF_WBR), 512, 0, 1024, gtid, gstride);
  transpose_convert(p.w_br_gla, 1024, 0, (bf16_t*)(ws + OFF_WBR + MiB), 512, 0, 1024, gtid, gstride);
  transpose_convert(p.w_br_xa, 1024, 0, (bf16_t*)(ws + OFF_WBR + 2 * MiB), 512, 0, 1024, gtid, gstride);
  transpose_convert(p.w_out, 1024, 0, (bf16_t*)(ws + OFF_WOUT), 1024, 0, 1024, gtid, gstride);
  transpose_convert(p.peer_w_q, 2048, 0, (bf16_t*)(ws + OFF_WQ), 1024, 0, 2048, gtid, gstride);
  convert_flat(p.peer_sub_keys, (bf16_t*)(ws + OFF_SUBK), 2 * 128 * 128, gtid, gstride);
  for (long i = gtid; i < T_; i += gstride) ((float*)(ws + OFF_ROWSS))[i] = 0.f;
  const int gwave = (int)(gtid >> 6), nwaves = (int)(gstride >> 6);
  quant_rows_fp8(p.peer_u, (unsigned*)(ws + OFF_U), (float*)(ws + OFF_SU), 16384, gwave, nwaves);
  quant_rows_fp8(p.peer_v, (unsigned*)(ws + OFF_V), (float*)(ws + OFF_SV), 16384, gwave, nwaves);
  rmsnorm_rows(p.x, p.mix_norm_w, (bf16_t*)((char*)p.out + OUT_XN), T_, gwave, nwaves);
  rmsnorm_rows(p.mem, p.mem_norm_w, (bf16_t*)(ws + OFF_MEMN), 2048, gwave, nwaves);
  if (gtid == 0) {
    float s0 = 0.f, s1 = 0.f;
    for (int i = 0; i < 64; i++) { s0 += p.da_lambda[i] * p.da_lambda[64 + i]; s1 += p.da_lambda[128 + i] * p.da_lambda[192 + i]; }
    float* misc = (float*)(ws + OFF_MISC);
    misc[0] = expf(s0) - expf(s1) + 0.2f;
    float mq = 0.f, mk = 0.f;
    for (int i = 0; i < 64; i++) { mq = fmaxf(mq, fabsf(p.da_q_norm_w[i])); mk = fmaxf(mk, fabsf(p.da_k_norm_w[i])); }
    misc[1] = 8.f * LOG2E * mq * mk * 1.001f;
    for (int i = 0; i < 8; i++) ((unsigned*)misc)[16 + i] = 0u;
  }
}

constexpr int NT_IN = 29, N_INPROJ_TILES = 512 * NT_IN, N_MEMKV_TILES = 16 * 8;

template <int GS>
DI void epi_norm_store(const f32x4 (&acc)[2][8], const float* __restrict__ w, float scale, bf16_t* __restrict__ dst, long ldd, int w_, int r16, int quad) {
#pragma unroll
  for (int mt = 0; mt < 2; mt++) {
    const int m = 32 * w_ + 16 * mt + r16;
#pragma unroll
    for (int g = 0; g < 128 / GS; g++) {
      float ss = 0.f;
#pragma unroll
      for (int nt = g * (GS / 16); nt < (g + 1) * (GS / 16); nt++)
#pragma unroll
        for (int i = 0; i < 4; i++) ss += acc[mt][nt][i] * acc[mt][nt][i];
      ss = quadsum(ss);
      const float rs = rsqrtf(ss * (1.f / GS) + EPS) * scale;
#pragma unroll
      for (int nt = g * (GS / 16); nt < (g + 1) * (GS / 16); nt++) {
        const int col = 16 * nt + 4 * quad;
        const f32x4 ww = *(const f32x4*)(w + (col & (GS - 1)));
        u32x2 o = u32x2{pack2(acc[mt][nt][0] * rs * ww.x, acc[mt][nt][1] * rs * ww.y), pack2(acc[mt][nt][2] * rs * ww.z, acc[mt][nt][3] * rs * ww.w)};
        *(u32x2*)(dst + (long)m * ldd + col) = o;
      }
    }
  }
}
DI void epi_plain_store(const f32x4 (&acc)[2][8], float scale, bf16_t* __restrict__ dst, long ldd, int w_, int r16, int quad) {
#pragma unroll
  for (int mt = 0; mt < 2; mt++) {
    const int m = 32 * w_ + 16 * mt + r16;
#pragma unroll
    for (int nt = 0; nt < 8; nt++) {
      const int col = 16 * nt + 4 * quad;
      u32x2 o = u32x2{pack2(acc[mt][nt][0] * scale, acc[mt][nt][1] * scale), pack2(acc[mt][nt][2] * scale, acc[mt][nt][3] * scale)};
      *(u32x2*)(dst + (long)m * ldd + col) = o;
    }
  }
}
DI void epi_trans_store(const f32x4 (&acc)[2][8], bf16_t* __restrict__ dst, long ldd, int w_, int r16, int quad, bf16_t* sT) {
  __syncthreads();
#pragma unroll
  for (int mt = 0; mt < 2; mt++) {
    const int m = 32 * w_ + 16 * mt + r16;
#pragma unroll
    for (int nt = 0; nt < 8; nt++)
#pragma unroll
      for (int i = 0; i < 4; i++) sT[(16 * nt + 4 * quad + i) * 136 + m] = f2bf(acc[mt][nt][i]);
  }
  __syncthreads();
  const int tid = threadIdx.x;
#pragma unroll
  for (int i = 0; i < 8; i++) {
    const int c = tid + 256 * i, n = c >> 4, mc = (c & 15) * 8;
    *(u32x4*)(dst + (long)n * ldd + mc) = *(const u32x4*)(sT + n * 136 + mc);
  }
}

DI void phase1_tile(const P& p, int tile, bf16_t* sA, bf16_t* sB) {
  const int tid = threadIdx.x, lane = tid & 63, w = tid >> 6, r16 = lane & 15, quad = lane >> 4;
  char* ws = p.ws;
  f32x4 acc[2][8];
  zero_acc(acc);
  if (tile < N_INPROJ_TILES) {
    const int xcd = tile & 7, j = tile >> 3;
    int ng = j / (64 * 8), rem = j - ng * 64 * 8, gsz = 8;
    if (ng >= 3) { ng = 3; rem = j - 3 * 64 * 8; gsz = 5; }
    const int mp = (rem / gsz) * 8 + xcd, nt_ = ng * 8 + rem % gsz;
    const bf16_t* A = (const bf16_t*)((const char*)p.out + OUT_XN) + (long)mp * 128 * 1024;
    const bf16_t* Bt = (const bf16_t*)(ws + OFF_WIN) + (long)nt_ * 128 * 1024;
    gemm_tile<64, 2>(A, 1024, Bt, 1024, 1024, acc, (char*)sA);
    const long m0 = (long)mp * 128;
    if (nt_ < 4) {
      epi_norm_store<64>(acc, p.da_q_norm_w, 0.125f * LOG2E, (bf16_t*)(ws + OFF_DAQ) + m0 * 512 + nt_ * 128, 512, w, r16, quad);
    } else if (nt_ < 8) {
      epi_norm_store<64>(acc, p.da_k_norm_w, 1.f, (bf16_t*)(ws + OFF_DAK) + m0 * 512 + (nt_ - 4) * 128, 512, w, r16, quad);
    } else if (nt_ < 12) {
      const int b = (int)(m0 / S_), s0 = (int)(m0 % S_), h = nt_ - 8;
      epi_trans_store(acc, (bf16_t*)(ws + OFF_DAVT) + ((long)(b * 4 + h) * 128) * S_ + s0, S_, w, r16, quad, sA);
    } else if (nt_ < 14) {
      epi_plain_store(acc, 0.125f, (bf16_t*)(ws + OFF_GLQ) + m0 * 256 + (nt_ - 12) * 128, 256, w, r16, quad);
    } else if (nt_ < 16) {
      epi_plain_store(acc, 1.f, (bf16_t*)(ws + OFF_GLK) + m0 * 256 + (nt_ - 14) * 128, 256, w, r16, quad);
    } else if (nt_ < 20) {
      epi_plain_store(acc, 1.f, (bf16_t*)(ws + OFF_GLV) + m0 * 512 + (nt_ - 16) * 128, 512, w, r16, quad);
    } else if (nt_ < 24) {
      epi_plain_store(acc, 1.f, (bf16_t*)(ws + OFF_GLR) + m0 * 512 + (nt_ - 20) * 128, 512, w, r16, quad);
    } else if (nt_ < 28) {
      epi_norm_store<128>(acc, p.xa_q_norm_w, 0.08838834764831845f * LOG2E, (bf16_t*)(ws + OFF_XAQ) + m0 * 512 + (nt_ - 24) * 128, 512, w, r16, quad);
    } else {
      float* glg = (float*)(ws + OFF_GLG);
#pragma unroll
      for (int mt = 0; mt < 2; mt++) {
        const long m = m0 + 32 * w + 16 * mt + r16;
        *(f32x4*)(glg + m * 16 + 4 * quad) = acc[mt][0];
      }
    }
  } else {
    const int t2 = tile - N_INPROJ_TILES, mp = t2 >> 3, nt_ = t2 & 7;
    const bf16_t* A = (const bf16_t*)(ws + OFF_MEMN) + (long)mp * 128 * 1024;
    const bf16_t* Bt = (const bf16_t*)(ws + OFF_WMEM) + (long)nt_ * 128 * 1024;
    gemm_tile<64, 2>(A, 1024, Bt, 1024, 1024, acc, (char*)sA);
    const long m0 = (long)mp * 128;
    if (nt_ < 4) {
      epi_norm_store<128>(acc, p.xa_k_norm_w, 1.f, (bf16_t*)(ws + OFF_MK) + m0 * 512 + nt_ * 128, 512, w, r16, quad);
    } else {
      const int b = (int)(m0 / 256), mm0 = (int)(m0 % 256), h = nt_ - 4;
      epi_trans_store(acc, (bf16_t*)(ws + OFF_MVT) + ((long)(b * 4 + h) * 128) * 256 + mm0, 256, w, r16, quad, sA);
    }
  }
}

constexpr int LDK = 136, LDV = 72;
template <int DQK, int NCOMP, bool CAUSAL, bool NORM, bool FIXM>
DI void attn_item(const bf16_t* __restrict__ Q, int ldq, const bf16_t* __restrict__ Kp, int ldk, const bf16_t* __restrict__ VT, int ldv, int ntiles, int q0,
                  float slope2, float lam, const float* __restrict__ normw, float outscale, bf16_t* __restrict__ O, int ldo, bf16_t* sK, bf16_t* sV, float mfix) {
  const int tid = threadIdx.x, lane = tid & 63, w = tid >> 6, r16 = lane & 15, quad = lane >> 4;
  constexpr int KS = DQK / 32;
  bf16x8 qf[NCOMP][KS];
#pragma unroll
  for (int c = 0; c < NCOMP; c++)
#pragma unroll
    for (int ks = 0; ks < KS; ks++) qf[c][ks] = *(const bf16x8*)(Q + (long)(16 * w + r16) * ldq + c * DQK + ks * 32 + quad * 8);
  f32x4 oacc[NCOMP][8];
  float mrun[NCOMP], lrun[NCOMP];
#pragma unroll
  for (int c = 0; c < NCOMP; c++) {
    mrun[c] = -1e30f; lrun[c] = 0.f;
#pragma unroll
    for (int et = 0; et < 8; et++) oacc[c][et] = f32x4{0.f, 0.f, 0.f, 0.f};
  }
  const int tq = q0 + 16 * w + r16;
  const int wu = __builtin_amdgcn_readfirstlane(w);
  char* const sbase = (char*)sK;
  auto issue_tile = [&](int kt_, int buf) {
    const int k1 = kt_ * 64;
    char* kb = sbase + buf * 32768;
    char* vb = kb + 16384;
#pragma unroll
    for (int j = 0; j < 4; j++) {
      const int rk_ = 4 * j + (lane >> 4);
      const bf16_t* gk = Kp + (long)(k1 + 16 * wu + rk_) * ldk + (((lane & 15) ^ rk_) * 8);
      glds16(gk, __builtin_amdgcn_readfirstlane(lds_addr(kb + (16 * wu + 4 * j) * 256)));
      const int rv_ = 32 * wu + 8 * j + (lane >> 3);
      const bf16_t* gv = VT + (long)rv_ * ldv + k1 + (((lane & 7) ^ ((rv_ >> 1) & 7)) * 8);
      glds16(gv, __builtin_amdgcn_readfirstlane(lds_addr(vb + (32 * wu + 8 * j) * 128)));
    }
  };
  issue_tile(0, 0);
  const int vsw = (r16 >> 1) & 7;
#pragma unroll 1
  for (int kt = 0; kt < ntiles; kt++) {
    asm volatile("s_waitcnt vmcnt(0)" ::: "memory");
    __syncthreads();
    if (kt + 1 < ntiles) issue_tile(kt + 1, (kt + 1) & 1);
    const bf16_t* sKb = (const bf16_t*)(sbase + (kt & 1) * 32768);
    const bf16_t* sVb = (const bf16_t*)(sbase + (kt & 1) * 32768 + 16384);
    __builtin_amdgcn_sched_barrier(0);
    const int k0 = kt * 64;
    if (CAUSAL && k0 > q0 + 16 * w + 15) continue;
    const bool diag = CAUSAL && (k0 + 63 > q0 + 16 * w);
    const float base_t = (CAUSAL ? slope2 * (float)(k0 + 4 * quad - tq) : 0.f) - (FIXM ? mfix : 0.f);
    bf16x8 pf[NCOMP][2];
#pragma unroll
    for (int c = 0; c < NCOMP; c++) {
      f32x4 s[4];
#pragma unroll
      for (int mt = 0; mt < 4; mt++) {
        if (CAUSAL) {
#pragma unroll
          for (int i = 0; i < 4; i++) s[mt][i] = fmaf(slope2, (float)(16 * mt + i), base_t);
        } else {
          s[mt] = f32x4{base_t, base_t, base_t, base_t};
        }
      }
#pragma unroll
      for (int ks = 0; ks < KS; ks++)
#pragma unroll
        for (int mt = 0; mt < 4; mt++) {
          bf16x8 kf = *(const bf16x8*)(sKb + (16 * mt + r16) * 128 + (((c * DQK / 8 + ks * 4 + quad) ^ r16) * 8));
          s[mt] = mfma16(kf, qf[c][ks], s[mt]);
        }
      if (diag) {
#pragma unroll
        for (int mt = 0; mt < 4; mt++)
#pragma unroll
          for (int i = 0; i < 4; i++)
            if (k0 + 16 * mt + 4 * quad + i > tq) s[mt][i] = -1e30f;
      }
      float mref = 0.f;
      if (!FIXM) {
        float mx = -1e30f;
#pragma unroll
        for (int mt = 0; mt < 4; mt++)
#pragma unroll
          for (int i = 0; i < 4; i++) mx = fmaxf(mx, s[mt][i]);
        mx = quadmax(mx);
        const float mnew = fmaxf(mrun[c], mx);
        const float alpha = fexp2(mrun[c] - mnew);
        mrun[c] = mnew;
        lrun[c] *= alpha;
#pragma unroll
        for (int et = 0; et < 8; et++) oacc[c][et] *= alpha;
        mref = mnew;
      }
      float ls = 0.f;
#pragma unroll
      for (int mt = 0; mt < 4; mt++)
#pragma unroll
        for (int i = 0; i < 4; i++) { s[mt][i] = fexp2(FIXM ? s[mt][i] : s[mt][i] - mref); ls += s[mt][i]; }
      lrun[c] += ls;
#pragma unroll
      for (int ks2 = 0; ks2 < 2; ks2++)
        pf[c][ks2] = pack8_mfma(s[2 * ks2][0], s[2 * ks2][1], s[2 * ks2][2], s[2 * ks2][3], s[2 * ks2 + 1][0], s[2 * ks2 + 1][1], s[2 * ks2 + 1][2], s[2 * ks2 + 1][3]);
    }
    __builtin_amdgcn_sched_barrier(0);
#pragma unroll
    for (int ks2 = 0; ks2 < 2; ks2++) {
#pragma unroll
      for (int et = 0; et < 8; et++) {
        const bf16_t* vrow_ = sVb + (16 * et + r16) * 64 + (quad & 1) * 4;
        s16x4 lo = *(const s16x4*)(vrow_ + (((4 * ks2 + (quad >> 1)) ^ vsw) * 8)), hi = *(const s16x4*)(vrow_ + (((4 * ks2 + 2 + (quad >> 1)) ^ vsw) * 8));
        bf16x8 vf = __builtin_shufflevector(lo, hi, 0, 1, 2, 3, 4, 5, 6, 7);
#pragma unroll
        for (int c = 0; c < NCOMP; c++) oacc[c][et] = mfma16(vf, pf[c][ks2], oacc[c][et]);
      }
    }
    __builtin_amdgcn_sched_barrier(0);
  }
  float inv[NCOMP];
#pragma unroll
  for (int c = 0; c < NCOMP; c++) inv[c] = 1.f / quadsum(lrun[c]);
  f32x4 o[8];
  float ss = 0.f;
#pragma unroll
  for (int et = 0; et < 8; et++) {
#pragma unroll
    for (int i = 0; i < 4; i++) {
      float v = oacc[0][et][i] * inv[0];
      if (NCOMP == 2) v -= lam * oacc[NCOMP - 1][et][i] * inv[NCOMP - 1];
      o[et][i] = v;
      ss += v * v;
    }
  }
  float rs = 1.f;
  if (NORM) { ss = quadsum(ss); rs = rsqrtf(ss * (1.f / 128.f) + EPS) * outscale; }
#pragma unroll
  for (int et = 0; et < 8; et++) {
    const int e = 16 * et + 4 * quad;
    f32x4 ww = f32x4{1.f, 1.f, 1.f, 1.f};
    if (NORM) ww = *(const f32x4*)(normw + e);
    u32x2 ov = u32x2{pack2(o[et][0] * rs * ww.x, o[et][1] * rs * ww.y), pack2(o[et][2] * rs * ww.z, o[et][3] * rs * ww.w)};
    *(u32x2*)(O + (long)(16 * w + r16) * ldo + e) = ov;
  }
}

DI void gla_compute_b(const P& p, int h, long t0, float (&bl)[16], float& btot, float* sG, float* sTot) {
  const int tid = threadIdx.x, d = tid & 63, seg = tid >> 6;
  const float* glg = (const float*)(p.ws + OFF_GLG) + t0 * 16;
  ((f32x4*)sG)[tid] = ((const f32x4*)glg)[tid];
  float wg[16];
#pragma unroll
  for (int r = 0; r < 16; r++) wg[r] = p.gla_w_gate[r * 256 + h * 64 + d];
  const float bg = p.gla_b_gate[h * 64 + d];
  __syncthreads();
  float run = 0.f;
#pragma unroll
  for (int tt = 0; tt < 16; tt++) {
    const float* g = sG + (seg * 16 + tt) * 16;
    float z = bg;
#pragma unroll
    for (int r = 0; r < 16; r++) z += g[r] * wg[r];
    const float la = (fminf(z, 0.f) - __logf(1.f + __expf(-fabsf(z)))) * (1.f / 16.f);
    run += la;
    bl[tt] = run;
    if ((tt & 3) == 3) __builtin_amdgcn_sched_barrier(0);
  }
  sTot[seg * 64 + d] = run;
  __syncthreads();
  float off = 0.f, tot = 0.f;
#pragma unroll
  for (int s2 = 0; s2 < 4; s2++) { const float v = sTot[s2 * 64 + d]; tot += v; if (s2 < seg) off += v; }
#pragma unroll
  for (int tt = 0; tt < 16; tt++) bl[tt] += off;
  btot = tot;
}
DI void gla_fetch_v(const P& p, int h, long t0, unsigned (&pk)[16]) {
  const int tid = threadIdx.x, e = tid & 127, half = tid >> 7;
  const bf16_t* gv = (const bf16_t*)(p.ws + OFF_GLV) + (t0 + half * 32) * 512 + h * 128 + e;
#pragma unroll
  for (int q = 0; q < 16; q++) {
    const unsigned a = gv[(long)(2 * q) * 512], b = gv[(long)(2 * q + 1) * 512];
    pk[q] = a | (b << 16);
  }
}
DI void gla_store_v(bf16_t* sVT, const unsigned (&pk)[16]) {
  const int tid = threadIdx.x, e = tid & 127, half = tid >> 7;
#pragma unroll
  for (int j = 0; j < 4; j++) *(u32x4*)(sVT + e * LDT + half * 32 + j * 8) = u32x4{pk[4 * j], pk[4 * j + 1], pk[4 * j + 2], pk[4 * j + 3]};
}

DI void gla_local_item(const P& p, int item, char* smem) {
  const int tid = threadIdx.x, lane = tid & 63, w = tid >> 6, r16 = lane & 15, quad = lane >> 4;
  const int bh = item >> 7, c = item & 127, b = bh >> 2, h = bh & 3;
  const long t0 = (long)b * S_ + c * 64;
  bf16_t* sKT = (bf16_t*)smem;
  bf16_t* sVT = (bf16_t*)(smem + 9216);
  float* sG = (float*)(smem + 9216 + 18432);
  float* sTot = (float*)(smem + 9216 + 18432 + 4096);
  __syncthreads();
  const int d = tid & 63, seg = tid >> 6;
  const bf16_t* gk = (const bf16_t*)(p.ws + OFF_GLK) + (t0 + seg * 16) * 256 + h * 64 + d;
  bf16_t kraw[16];
#pragma unroll
  for (int q = 0; q < 16; q++) kraw[q] = gk[(long)q * 256];
  unsigned vpk[16];
  gla_fetch_v(p, h, t0, vpk);
  float bl[16], btot;
  gla_compute_b(p, h, t0, bl, btot, sG, sTot);
  unsigned pk[8];
#pragma unroll
  for (int q = 0; q < 8; q++) {
    const float k0v = bf2f(kraw[2 * q]) * __expf(btot - bl[2 * q]);
    const float k1v = bf2f(kraw[2 * q + 1]) * __expf(btot - bl[2 * q + 1]);
    pk[q] = pack2(k0v, k1v);
  }
  *(u32x4*)(sKT + d * LDT + seg * 16) = u32x4{pk[0], pk[1], pk[2], pk[3]};
  *(u32x4*)(sKT + d * LDT + seg * 16 + 8) = u32x4{pk[4], pk[5], pk[6], pk[7]};
  if (seg == 0) ((float*)(p.ws + OFF_DEC))[(long)item * 64 + d] = __expf(btot);
  gla_store_v(sVT, vpk);
  __syncthreads();
  bf16_t* ST = (bf16_t*)((char*)p.out + OUT_ST) + (long)item * 8192;
#pragma unroll
  for (int n2 = 0; n2 < 2; n2++) {
    const int nt = 2 * w + n2;
    f32x4 acc[4];
#pragma unroll
    for (int mt = 0; mt < 4; mt++) acc[mt] = f32x4{0.f, 0.f, 0.f, 0.f};
#pragma unroll
    for (int ks = 0; ks < 2; ks++) {
      bf16x8 vf = *(const bf16x8*)(sVT + (16 * nt + r16) * LDT + ks * 32 + quad * 8);
#pragma unroll
      for (int mt = 0; mt < 4; mt++) {
        bf16x8 kf = *(const bf16x8*)(sKT + (16 * mt + r16) * LDT + ks * 32 + quad * 8);
        acc[mt] = mfma16(kf, vf, acc[mt]);
      }
    }
#pragma unroll
    for (int mt = 0; mt < 4; mt++) {
      u32x2 o = u32x2{pack2(acc[mt][0], acc[mt][1]), pack2(acc[mt][2], acc[mt][3])};
      *(u32x2*)(ST + (16 * nt + r16) * 64 + 16 * mt + 4 * quad) = o;
    }
  }
}

DI void gla_scan(const P& p) {
  const long gtid = (long)blockIdx.x * blockDim.x + threadIdx.x, gstride = (long)gridDim.x * blockDim.x;
  for (long g = gtid; g < 32 * 2048; g += gstride) {
    const int bh = (int)(g >> 11), eg = (int)(g & 2047), d = (eg * 4) & 63;
    bf16_t* ST = (bf16_t*)((char*)p.out + OUT_ST) + (long)bh * 128 * 8192 + eg * 4;
    const float* DEC = (const float*)(p.ws + OFF_DEC) + (long)bh * 128 * 64 + d;
    float st[4] = {0.f, 0.f, 0.f, 0.f};
#pragma unroll 4
    for (int c = 0; c < 128; c++) {
      const u32x2 loc = *(const u32x2*)(ST + (long)c * 8192);
      const f32x4 dec = *(const f32x4*)(DEC + c * 64);
      *(u32x2*)(ST + (long)c * 8192) = u32x2{pack2(st[0], st[1]), pack2(st[2], st[3])};
      st[0] = st[0] * dec.x + lo2f(loc.x);
      st[1] = st[1] * dec.y + hi2f(loc.x);
      st[2] = st[2] * dec.z + lo2f(loc.y);
      st[3] = st[3] * dec.w + hi2f(loc.y);
    }
  }
}

DI void gla_out_item(const P& p, int item, char* smem) {
  const int tid = threadIdx.x, lane = tid & 63, w = tid >> 6, r16 = lane & 15, quad = lane >> 4;
  const int bh = item >> 7, c = item & 127, b = bh >> 2, h = bh & 3;
  const long t0 = (long)b * S_ + c * 64;
  bf16_t* sQ = (bf16_t*)smem;
  bf16_t* sK = (bf16_t*)(smem + 9216);
  bf16_t* sVT = (bf16_t*)(smem + 18432);
  bf16_t* sST = (bf16_t*)(smem + 36864);
  float* sG = (float*)(smem + 36864);
  float* sTot = (float*)(smem + 36864 + 4096);
  __syncthreads();
  const int d = tid & 63, seg = tid >> 6;
  const bf16_t* gq = (const bf16_t*)(p.ws + OFF_GLQ) + (t0 + seg * 16) * 256 + h * 64 + d;
  const bf16_t* gk = (const bf16_t*)(p.ws + OFF_GLK) + (t0 + seg * 16) * 256 + h * 64 + d;
  bf16_t qraw[16], kraw[16];
#pragma unroll
  for (int tt = 0; tt < 16; tt++) { qraw[tt] = gq[(long)tt * 256]; kraw[tt] = gk[(long)tt * 256]; }
  unsigned vpk[16];
  gla_fetch_v(p, h, t0, vpk);
  u32x4 straw[4];
  {
    const bf16_t* ST = (const bf16_t*)((const char*)p.out + OUT_ST) + (long)item * 8192;
#pragma unroll
    for (int i = 0; i < 4; i++) {
      const int cidx = tid + 256 * i, row = cidx >> 3, kc = (cidx & 7) * 8;
      straw[i] = *(const u32x4*)(ST + row * 64 + kc);
    }
  }
  float bl[16], btot;
  gla_compute_b(p, h, t0, bl, btot, sG, sTot);
#pragma unroll
  for (int tt = 0; tt < 16; tt++) {
    const float eb = __expf(bl[tt]);
    sQ[(seg * 16 + tt) * LDT + d] = f2bf(bf2f(qraw[tt]) * eb);
    sK[(seg * 16 + tt) * LDT + d] = f2bf(bf2f(kraw[tt]) * frcp(eb));
  }
  gla_store_v(sVT, vpk);
  __syncthreads();
#pragma unroll
  for (int i = 0; i < 4; i++) {
    const int cidx = tid + 256 * i, row = cidx >> 3, kc = (cidx & 7) * 8;
    *(u32x4*)(sST + row * LDT + kc) = straw[i];
  }
  __syncthreads();
  const int t = 16 * w + r16;
  bf16x8 qf[2];
#pragma unroll
  for (int ks = 0; ks < 2; ks++) qf[ks] = *(const bf16x8*)(sQ + t * LDT + ks * 32 + quad * 8);
  f32x4 a[4];
#pragma unroll
  for (int mt = 0; mt < 4; mt++) a[mt] = f32x4{0.f, 0.f, 0.f, 0.f};
#pragma unroll
  for (int ks = 0; ks < 2; ks++)
#pragma unroll
    for (int mt = 0; mt < 4; mt++) {
      bf16x8 kf = *(const bf16x8*)(sK + (16 * mt + r16) * LDT + ks * 32 + quad * 8);
      a[mt] = mfma16(kf, qf[ks], a[mt]);
    }
#pragma unroll
  for (int mt = 0; mt < 4; mt++)
#pragma unroll
    for (int i = 0; i < 4; i++)
      if (16 * mt + 4 * quad + i > t) a[mt][i] = 0.f;
  bf16x8 pf[2];
#pragma unroll
  for (int ks2 = 0; ks2 < 2; ks2++) {
    pf[ks2] = pack8_mfma(a[2 * ks2][0], a[2 * ks2][1], a[2 * ks2][2], a[2 * ks2][3], a[2 * ks2 + 1][0], a[2 * ks2 + 1][1], a[2 * ks2 + 1][2], a[2 * ks2 + 1][3]);
  }
  f32x4 o[8];
  float ss = 0.f;
#pragma unroll
  for (int et = 0; et < 8; et++) {
    f32x4 acc = f32x4{0.f, 0.f, 0.f, 0.f};
#pragma unroll
    for (int ks = 0; ks < 2; ks++) {
      bf16x8 sf = *(const bf16x8*)(sST + (16 * et + r16) * LDT + ks * 32 + quad * 8);
      acc = mfma16(sf, qf[ks], acc);
    }
#pragma unroll
    for (int ks2 = 0; ks2 < 2; ks2++) {
      const bf16_t* vp = sVT + (16 * et + r16) * LDT + 32 * ks2 + 4 * quad;
      s16x4 lo = *(const s16x4*)vp, hi = *(const s16x4*)(vp + 16);
      bf16x8 vf = __builtin_shufflevector(lo, hi, 0, 1, 2, 3, 4, 5, 6, 7);
      acc = mfma16(vf, pf[ks2], acc);
    }
    o[et] = acc;
#pragma unroll
    for (int i = 0; i < 4; i++) ss += acc[i] * acc[i];
  }
  ss = quadsum(ss);
  const float rs = rsqrtf(ss * (1.f / 128.f) + EPS);
  bf16_t* R = (bf16_t*)(p.ws + OFF_GLR) + (t0 + t) * 512 + h * 128;
#pragma unroll
  for (int et = 0; et < 8; et++) {
    const int e = 16 * et + 4 * quad;
    const f32x4 ww = *(const f32x4*)(p.gla_out_norm_w + e);
    const u32x2 rr = *(const u32x2*)(R + e);
    const float r0 = lo2f(rr.x), r1 = hi2f(rr.x), r2 = lo2f(rr.y), r3 = hi2f(rr.y);
    const float y0 = o[et][0] * rs * ww.x * (r0 / (1.f + __expf(-r0)));
    const float y1 = o[et][1] * rs * ww.y * (r1 / (1.f + __expf(-r1)));
    const float y2 = o[et][2] * rs * ww.z * (r2 / (1.f + __expf(-r2)));
    const float y3 = o[et][3] * rs * ww.w * (r3 / (1.f + __expf(-r3)));
    *(u32x2*)(R + e) = u32x2{pack2(y0, y1), pack2(y2, y3)};
  }
}

constexpr int N_P2_ITEMS = 12288;
#ifndef P2_SUB
#define P2_SUB 7
#endif
#define P2S(n) (((P2_SUB) >> (n)) & 1)
DI void phase2_item(const P& p, int item, char* smem) {
  char* ws = p.ws;
  if (P2S(0) && item < 4096) {
    const int qb = 127 - (item >> 5), bh = item & 31, b = bh >> 2, h = bh & 3;
    const long trow = (long)b * S_ + qb * 64;
    const float slope = exp2f(-2.f * (float)(h + 1));
    const float lam = ((const float*)(ws + OFF_MISC))[0];
    bf16_t* Q = (bf16_t*)(ws + OFF_DAQ) + trow * 512 + h * 128;
    const bf16_t* Kp = (const bf16_t*)(ws + OFF_DAK) + (long)b * S_ * 512 + h * 128;
    const bf16_t* VT = (const bf16_t*)(ws + OFF_DAVT) + (long)(b * 4 + h) * 128 * S_;
    const float mfix = ((const float*)(ws + OFF_MISC))[1];
    if (mfix <= 40.f)
      attn_item<64, 2, true, true, true>(Q, 512, Kp, 512, VT, S_, qb + 1, qb * 64, slope * LOG2E, lam, p.da_out_norm_w, 0.8f, Q, 512, (bf16_t*)smem,
                                         (bf16_t*)(smem + 64 * LDK * 2), mfix);
    else
      attn_item<64, 2, true, true, false>(Q, 512, Kp, 512, VT, S_, qb + 1, qb * 64, slope * LOG2E, lam, p.da_out_norm_w, 0.8f, Q, 512, (bf16_t*)smem,
                                          (bf16_t*)(smem + 64 * LDK * 2), 0.f);
  } else if (P2S(1) && item < 8192) {
    const int it = item - 4096, qb = it >> 5, bh = it & 31, b = bh >> 2, h = bh & 3;
    const long trow = (long)b * S_ + qb * 64;
    bf16_t* Q = (bf16_t*)(ws + OFF_XAQ) + trow * 512 + h * 128;
    const bf16_t* Kp = (const bf16_t*)(ws + OFF_MK) + (long)b * 256 * 512 + h * 128;
    const bf16_t* VT = (const bf16_t*)(ws + OFF_MVT) + (long)(b * 4 + h) * 128 * 256;
    attn_item<128, 1, false, false, false>(Q, 512, Kp, 512, VT, 256, 4, 0, 0.f, 0.f, nullptr, 1.f, Q, 512, (bf16_t*)smem, (bf16_t*)(smem + 64 * LDK * 2), 0.f);
  } else if (P2S(2)) {
    { const int it = item - 8192; gla_local_item(p, (it & 31) * 128 + (it >> 5), smem); }
  }
}

DI void phase5_tile(const P& p, int tile, bf16_t* sA, bf16_t* sB, u32x2* sM) {
  const int tid = threadIdx.x, lane = tid & 63, w = tid >> 6, r16 = lane & 15, quad = lane >> 4;
  char* ws = p.ws;
  const int xcd = tile & 7, j = tile >> 3, mp = (j >> 3) * 8 + xcd, nt_ = j & 7;
  const long m0 = (long)mp * 128;
  bf16_t* dst = (bf16_t*)(ws + OFF_MERGED) + m0 * 1024 + nt_ * 128;
  u32x2 merged[2][8];
#pragma unroll
  for (int mt = 0; mt < 2; mt++)
#pragma unroll
    for (int nt = 0; nt < 8; nt++) merged[mt][nt] = u32x2{0u, 0u};
#pragma unroll 1
  for (int br = 0; br < 3; br++) {
    u32x2 ob[2][8];
    {
      f32x4 acc[2][8];
      zero_acc(acc);
      const size_t oo = br == 0 ? OFF_DAQ : (br == 1 ? OFF_GLR : OFF_XAQ);
      gemm_tile<64, 2>((const bf16_t*)(ws + oo) + m0 * 512, 512, (const bf16_t*)(ws + OFF_WBR + br * MiB) + (long)nt_ * 128 * 512, 512, 512, acc, (char*)sA);
#pragma unroll
      for (int mt = 0; mt < 2; mt++)
#pragma unroll
        for (int nt = 0; nt < 8; nt++) ob[mt][nt] = u32x2{pack2(acc[mt][nt][0], acc[mt][nt][1]), pack2(acc[mt][nt][2], acc[mt][nt][3])};
    }
    __builtin_amdgcn_sched_barrier(0);
    f32x4 acc[2][8];
    zero_acc(acc);
    gemm_tile<64, 2>((const bf16_t*)((const char*)p.out + OUT_XN) + m0 * 1024, 1024, (const bf16_t*)(ws + OFF_WG) + (long)(br * 1024 + nt_ * 128) * 1024, 1024, 1024,
              acc, (char*)sA);
    __builtin_amdgcn_sched_barrier(0);
#pragma unroll
    for (int mt = 0; mt < 2; mt++) {
#pragma unroll
      for (int nt = 0; nt < 8; nt++) {
        const u32x2 mg = merged[mt][nt];
        const float v0 = lo2f(mg.x) + lo2f(ob[mt][nt].x) * frcp(1.f + __expf(-acc[mt][nt][0]));
        const float v1 = hi2f(mg.x) + hi2f(ob[mt][nt].x) * frcp(1.f + __expf(-acc[mt][nt][1]));
        const float v2 = lo2f(mg.y) + lo2f(ob[mt][nt].y) * frcp(1.f + __expf(-acc[mt][nt][2]));
        const float v3 = hi2f(mg.y) + hi2f(ob[mt][nt].y) * frcp(1.f + __expf(-acc[mt][nt][3]));
        merged[mt][nt] = u32x2{pack2(v0, v1), pack2(v2, v3)};
        __builtin_amdgcn_sched_barrier(0);
      }
    }
  }
#pragma unroll
  for (int mt = 0; mt < 2; mt++) {
    const int m = 32 * w + 16 * mt + r16;
#pragma unroll
    for (int nt = 0; nt < 8; nt++) *(u32x2*)(dst + (long)m * 1024 + 16 * nt + 4 * quad) = merged[mt][nt];
  }
}
DI void phase6_tile(const P& p, int tile, bf16_t* sA, bf16_t* sB) {
  const int tid = threadIdx.x, lane = tid & 63, w = tid >> 6, r16 = lane & 15, quad = lane >> 4;
  char* ws = p.ws;
  const int xcd = tile & 7, j = tile >> 3, mp = (j >> 3) * 8 + xcd, nt_ = j & 7;
  const long m0 = (long)mp * 128;
  f32x4 acc[2][8];
  zero_acc(acc);
  gemm_tile<64, 2>((const bf16_t*)(ws + OFF_MERGED) + m0 * 1024, 1024, (const bf16_t*)(ws + OFF_WOUT) + (long)nt_ * 128 * 1024, 1024, 1024, acc, (char*)sA);
#pragma unroll
  for (int mt = 0; mt < 2; mt++) {
    const long m = m0 + 32 * w + 16 * mt + r16;
    float ss = 0.f;
#pragma unroll
    for (int nt = 0; nt < 8; nt++) {
      const int col = nt_ * 128 + 16 * nt + 4 * quad;
      const f32x4 xv = *(const f32x4*)(p.x + m * 1024 + col);
      const f32x4 y = f32x4{xv.x + acc[mt][nt][0], xv.y + acc[mt][nt][1], xv.z + acc[mt][nt][2], xv.w + acc[mt][nt][3]};
      *(f32x4*)(p.out + m * 1024 + col) = y;
      const f32x4 ww = *(const f32x4*)(p.ffn_norm_w + col);
      *(u32x2*)((bf16_t*)(ws + OFF_XN2) + m * 1024 + col) = u32x2{pack2(y.x * ww.x, y.y * ww.y), pack2(y.z * ww.z, y.w * ww.w)};
      ss += y.x * y.x + y.y * y.y + y.z * y.z + y.w * y.w;
    }
    ss = quadsum(ss);
    if (quad == 0) atomicAdd((float*)(ws + OFF_ROWSS) + m, ss);
  }
}

constexpr int LDSK = 136;
DI void peer_topk_item(const P& p, int item, char* smem) {
  const int tid = threadIdx.x, lane = tid & 63, w = tid >> 6, r16 = lane & 15, quad = lane >> 4;
  char* ws = p.ws;
  const int xcd = item & 7, j = item >> 3, mp = (j >> 3) * 8 + xcd, h = j & 7;
  const long m0 = (long)mp * 128;
  bf16_t* sA = (bf16_t*)smem;
  bf16_t* sB = (bf16_t*)(smem + 128 * LDT * 2);
  bf16_t* sSK = (bf16_t*)smem;
  float* sTopV = (float*)(smem + 36864);
  int* sTopI = (int*)(smem + 36864 + 16384);
#pragma unroll 1
  for (int pp = 0; pp < 2; pp++) {
    f32x4 acc[2][8];
    zero_acc(acc);
    gemm_tile<32, 2>((const bf16_t*)(ws + OFF_XN2) + m0 * 1024, 1024, (const bf16_t*)(ws + OFF_WQ) + (long)(h * 256 + pp * 128) * 1024, 1024, 1024, acc, (char*)sA);
    bf16x8 qf[2][4];
#pragma unroll
    for (int mt = 0; mt < 2; mt++)
#pragma unroll
      for (int ks = 0; ks < 4; ks++)
        qf[mt][ks] = pack8_mfma(acc[mt][2 * ks][0], acc[mt][2 * ks][1], acc[mt][2 * ks][2], acc[mt][2 * ks][3], acc[mt][2 * ks + 1][0], acc[mt][2 * ks + 1][1],
                                acc[mt][2 * ks + 1][2], acc[mt][2 * ks + 1][3]);
    __builtin_amdgcn_sched_barrier(0);
    __syncthreads();
    {
      const bf16_t* SK = (const bf16_t*)(ws + OFF_SUBK) + pp * 128 * 128;
#pragma unroll
      for (int i = 0; i < 8; i++) {
        const int cidx = tid + 256 * i, row = cidx >> 4, kc = (cidx & 15) * 8;
        *(u32x4*)(sSK + row * LDSK + kc) = *(const u32x4*)(SK + row * 128 + kc);
      }
    }
    __syncthreads();
#pragma unroll
    for (int mt = 0; mt < 2; mt++) {
      f32x4 sc[8];
#pragma unroll
      for (int nt = 0; nt < 8; nt++) sc[nt] = f32x4{0.f, 0.f, 0.f, 0.f};
#pragma unroll
      for (int ks = 0; ks < 4; ks++) {
#pragma unroll
        for (int nt = 0; nt < 8; nt++) {
          const bf16_t* kp = sSK + (16 * nt + r16) * LDSK + 32 * ks + 4 * quad;
          s16x4 lo = *(const s16x4*)kp, hi = *(const s16x4*)(kp + 16);
          bf16x8 kf = __builtin_shufflevector(lo, hi, 0, 1, 2, 3, 4, 5, 6, 7);
          sc[nt] = mfma16(kf, qf[mt][ks], sc[nt]);
        }
        __builtin_amdgcn_sched_barrier(0);
      }
      const int tok = 32 * w + 16 * mt + r16;
      unsigned key[8][4];
#pragma unroll
      for (int nt = 0; nt < 8; nt++)
#pragma unroll
        for (int i = 0; i < 4; i++) {
          const unsigned bits = __float_as_uint(sc[nt][i]);
          const unsigned srt = bits ^ ((unsigned)((int)bits >> 31) | 0x80000000u);
          key[nt][i] = (srt & 0xffffff80u) | (unsigned)(127 - 16 * nt - i - 4 * quad);
        }
#pragma unroll 1
      for (int r = 0; r < 16; r++) {
        unsigned gm = 0u;
#pragma unroll
        for (int nt = 0; nt < 8; nt++)
#pragma unroll
          for (int i = 0; i < 4; i++) gm = max(gm, key[nt][i]);
        gm = max(gm, (unsigned)__shfl_xor((int)gm, 16));
        gm = max(gm, (unsigned)__shfl_xor((int)gm, 32));
        if (quad == 0) {
          const unsigned srt = gm & 0xffffff80u;
          const unsigned bits = (srt & 0x80000000u) ? (srt ^ 0x80000000u) : ~srt;
          sTopV[(pp * 128 + tok) * 16 + r] = __uint_as_float(bits);
          sTopI[(pp * 128 + tok) * 16 + r] = 127 - (int)(gm & 0x7fu);
        }
#pragma unroll
        for (int nt = 0; nt < 8; nt++)
#pragma unroll
          for (int i = 0; i < 4; i++)
            if (key[nt][i] == gm) key[nt][i] = 0u;
      }
      __builtin_amdgcn_sched_barrier(0);
    }
  }
  __syncthreads();
  if (tid < 128) {
    const int tok = tid;
    float a[16], b[16];
#pragma unroll
    for (int i = 0; i < 16; i++) { a[i] = sTopV[tok * 16 + i]; b[i] = sTopV[(128 + tok) * 16 + i]; }
    unsigned cand[50];
    {
      int q = 0;
#pragma unroll
      for (int i = 0; i < 16; i++)
#pragma unroll
        for (int jj = 0; jj < 16; jj++)
          if ((i + 1) * (jj + 1) <= 16) {
            const unsigned bits = __float_as_uint(a[i] + b[jj]);
            const unsigned srt = bits ^ ((unsigned)((int)bits >> 31) | 0x80000000u);
            cand[q] = (srt & 0xffffff00u) | (unsigned)(255 - (i * 16 + jj));
            q++;
          }
    }
    int* PIDX = (int*)(ws + OFF_PIDX) + ((m0 + tok) * 8 + h) * 16;
    float* PG = (float*)(ws + OFF_PG) + ((m0 + tok) * 8 + h) * 16;
    float top0 = 0.f, gsum = 0.f;
    const float rstd_t = rsqrtf(((const float*)(ws + OFF_ROWSS))[m0 + tok] * (1.f / 1024.f) + EPS);
#pragma unroll 1
    for (int r = 0; r < 16; r++) {
      unsigned gm = 0u;
#pragma unroll
      for (int q = 0; q < 50; q++) gm = max(gm, cand[q]);
#pragma unroll
      for (int q = 0; q < 50; q++)
        if (cand[q] == gm) cand[q] = 0u;
      const unsigned srt = gm & 0xffffff00u;
      const float bv = __uint_as_float((srt & 0x80000000u) ? (srt ^ 0x80000000u) : ~srt);
      const int bc = 255 - (int)(gm & 0xffu);
      if (r == 0) top0 = bv;
      const float e = __expf((bv - top0) * rstd_t);
      gsum += e;
      PIDX[r] = sTopI[tok * 16 + (bc >> 4)] * 128 + sTopI[(128 + tok) * 16 + (bc & 15)];
      PG[r] = e;
    }
    const float ginv = 1.f / gsum;
#pragma unroll 1
    for (int r = 0; r < 16; r++) PG[r] *= ginv;
  }
}

typedef float f32x2 __attribute__((ext_vector_type(2)));
DI float dot16_fp8(u32x4 u, const float* xf) {
  float s = 0.f;
#pragma unroll
  for (int j = 0; j < 4; j++) {
    const f32x2 lo = __builtin_amdgcn_cvt_pk_f32_fp8((int)u[j], false), hi = __builtin_amdgcn_cvt_pk_f32_fp8((int)u[j], true);
    s += lo.x * xf[4 * j];
    s += lo.y * xf[4 * j + 1];
    s += hi.x * xf[4 * j + 2];
    s += hi.y * xf[4 * j + 3];
  }
  return s;
}
DI void fma16_fp8(float* o, u32x4 v, float c) {
#pragma unroll
  for (int j = 0; j < 4; j++) {
    const f32x2 lo = __builtin_amdgcn_cvt_pk_f32_fp8((int)v[j], false), hi = __builtin_amdgcn_cvt_pk_f32_fp8((int)v[j], true);
    o[4 * j] += c * lo.x;
    o[4 * j + 1] += c * lo.y;
    o[4 * j + 2] += c * hi.x;
    o[4 * j + 3] += c * hi.y;
  }
}
DI void peer_eval(const P& p) {
  const int lane = threadIdx.x & 63;
  const int gwave = blockIdx.x * 4 + (threadIdx.x >> 6), nwaves = gridDim.x * 4;
  const unsigned* U = (const unsigned*)(p.ws + OFF_U);
  const unsigned* V = (const unsigned*)(p.ws + OFF_V);
  const float* SU = (const float*)(p.ws + OFF_SU);
  const float* SV = (const float*)(p.ws + OFF_SV);
  const int myk = (lane >> 2) & 15;
  for (int t = gwave; t < T_; t += nwaves) {
    const u32x4* xr = (const u32x4*)((const bf16_t*)(p.ws + OFF_XN2) + (long)t * 1024 + lane * 16);
    const u32x4 x0 = xr[0], x1 = xr[1];
    float xf[16];
    xf[0] = lo2f(x0.x); xf[1] = hi2f(x0.x); xf[2] = lo2f(x0.y); xf[3] = hi2f(x0.y); xf[4] = lo2f(x0.z); xf[5] = hi2f(x0.z); xf[6] = lo2f(x0.w); xf[7] = hi2f(x0.w);
    xf[8] = lo2f(x1.x); xf[9] = hi2f(x1.x); xf[10] = lo2f(x1.y); xf[11] = hi2f(x1.y); xf[12] = lo2f(x1.z); xf[13] = hi2f(x1.z); xf[14] = lo2f(x1.w); xf[15] = hi2f(x1.w);
    float o[16];
#pragma unroll
    for (int i = 0; i < 16; i++) o[i] = 0.f;
    const float rstd_t = rsqrtf(((const float*)(p.ws + OFF_ROWSS))[t] * (1.f / 1024.f) + EPS);
#pragma unroll 1
    for (int h = 0; h < 8; h++) {
      const int eidx = ((const int*)(p.ws + OFF_PIDX))[((long)t * 8 + h) * 16 + myk];
      const float g = ((const float*)(p.ws + OFF_PG))[((long)t * 8 + h) * 16 + myk];
      const float su = SU[eidx], sv = SV[eidx];
      float part[16];
#pragma unroll
      for (int k = 0; k < 16; k++) {
        const int e = __builtin_amdgcn_readlane(eidx, 4 * k);
        const u32x4 u0 = *(const u32x4*)(U + (long)e * 256 + lane * 4);
        part[k] = dot16_fp8(u0, xf);
      }
      float p8[8], p4[4], p2[2], p1;
      {
        const bool hb = (lane & 32) != 0;
#pragma unroll
        for (int k = 0; k < 8; k++) { const float keep = hb ? part[k + 8] : part[k], send = hb ? part[k] : part[k + 8]; p8[k] = keep + __shfl_xor(send, 32); }
      }
      {
        const bool hb = (lane & 16) != 0;
#pragma unroll
        for (int k = 0; k < 4; k++) { const float keep = hb ? p8[k + 4] : p8[k], send = hb ? p8[k] : p8[k + 4]; p4[k] = keep + __shfl_xor(send, 16); }
      }
      {
        const bool hb = (lane & 8) != 0;
#pragma unroll
        for (int k = 0; k < 2; k++) { const float keep = hb ? p4[k + 2] : p4[k], send = hb ? p4[k] : p4[k + 2]; p2[k] = keep + __shfl_xor(send, 8); }
      }
      {
        const bool hb = (lane & 4) != 0;
        const float keep = hb ? p2[1] : p2[0], send = hb ? p2[0] : p2[1];
        p1 = keep + __shfl_xor(send, 4);
      }
      p1 += __shfl_xor(p1, 1);
      p1 += __shfl_xor(p1, 2);
      p1 *= su * rstd_t;
      const float act = 0.5f * p1 * (1.f + erff(p1 * 0.70710678118654752f));
      const float coef = g * act * sv;
#pragma unroll
      for (int k = 0; k < 16; k++) {
        const int e = __builtin_amdgcn_readlane(eidx, 4 * k);
        const float cf = __int_as_float(__builtin_amdgcn_readlane(__float_as_int(coef), 4 * k));
        const u32x4 v0 = *(const u32x4*)(V + (long)e * 256 + lane * 4);
        fma16_fp8(o, v0, cf);
      }
    }
    f32x4* orow = (f32x4*)(p.out + (long)t * 1024 + lane * 16);
#pragma unroll
    for (int j = 0; j < 4; j++) {
      const f32x4 a = orow[j];
      orow[j] = f32x4{a.x + o[4 * j], a.y + o[4 * j + 1], a.z + o[4 * j + 2], a.w + o[4 * j + 3]};
    }
  }
}

#define XB_TMO      128
#define XB_XCNT(j)  (256  + 64 * (j))
#define XB_XSUB(j)  (1280 + 64 * (j))
#define XB_XGEN(j)  (2304 + 64 * (j))
#define XB_TOP      3328
#define XB_TOPGEN   3392
#define XCD_BAR_WORDS 3456
#define XB_SPIN_CAP (1u << 18)
#define LAS __attribute__((address_space(3)))
DI unsigned xb_ld(unsigned* p) { return __hip_atomic_load(p, __ATOMIC_RELAXED, __HIP_MEMORY_SCOPE_AGENT); }
DI unsigned xb_add(unsigned* p, unsigned v) { return __hip_atomic_fetch_add(p, v, __ATOMIC_RELAXED, __HIP_MEMORY_SCOPE_AGENT); }
DI unsigned xb_xcc_id() { return (unsigned)__builtin_amdgcn_s_getreg((3 << 11) | 20) & 0xFu; }
#define XB_SPIN(cond, bar) do { unsigned _sp = 0; while (cond) { __builtin_amdgcn_s_sleep(1); \
    if ((++_sp & 255u) == 0u) { if (xb_ld(&(bar)[XB_TMO])) break; if (_sp > XB_SPIN_CAP) { atomicAdd(&(bar)[XB_TMO], 1u); break; } } } } while (0)
struct XcdBarrier { unsigned* bar; unsigned x; volatile LAS unsigned* st; };
DI XcdBarrier xcd_barrier_post(unsigned* bar, volatile LAS unsigned* st) {
  XcdBarrier b; b.bar = bar; b.x = xb_xcc_id(); b.st = st;
  if (threadIdx.x == 0) (void)xb_add(&bar[XB_XCNT(b.x)], 1u);
  return b;
}
DI void xcd_barrier_complete(unsigned* bar, unsigned x, unsigned& nloc, unsigned& nx) {
  const unsigned G = gridDim.x * gridDim.y * gridDim.z;
  unsigned sum, cnt, mine, sp = 0u;
  for (;;) {
    sum = 0u; cnt = 0u; mine = 0u;
#pragma unroll
    for (unsigned j = 0; j < 16; ++j) { const unsigned c = xb_ld(&bar[XB_XCNT(j)]); sum += c; cnt += (c > 0u) ? 1u : 0u; mine = (j == x) ? c : mine; }
    if (sum == G) break;
    __builtin_amdgcn_s_sleep(1);
    if ((++sp & 255u) == 0u) { if (xb_ld(&bar[XB_TMO])) break; if (sp > XB_SPIN_CAP) { atomicAdd(&bar[XB_TMO], 1u); break; } }
  }
  nloc = mine > 0u ? mine : 1u; nx = cnt > 0u ? cnt : 1u;
}
DI void xcd_barrier(const XcdBarrier& b) {
  asm volatile("s_waitcnt vmcnt(0)" ::: "memory");
  __syncthreads();
  if (threadIdx.x == 0) {
    unsigned* bar = b.bar;
    __builtin_amdgcn_s_waitcnt(0);
    unsigned nloc = b.st[0], nx = b.st[1];
    if (nloc == 0u) { xcd_barrier_complete(bar, b.x, nloc, nx); b.st[0] = nloc; b.st[1] = nx; }
    const unsigned old = xb_add(&bar[XB_XSUB(b.x)], 1u);
    const unsigned gen = old / nloc;
    if (old + 1u == (gen + 1u) * nloc) {
      __builtin_amdgcn_fence(__ATOMIC_RELEASE, "agent");
      asm volatile("s_waitcnt vmcnt(0)" ::: "memory");
      const unsigned og = xb_add(&bar[XB_TOP], 1u);
      const unsigned tg = og / nx;
      if (og + 1u == (tg + 1u) * nx) xb_add(&bar[XB_TOPGEN], 1u);
      else XB_SPIN(xb_ld(&bar[XB_TOPGEN]) == tg, bar);
      __builtin_amdgcn_fence(__ATOMIC_ACQUIRE, "agent");
      xb_add(&bar[XB_XGEN(b.x)], 1u);
      asm volatile("s_waitcnt vmcnt(0)" ::: "memory");
    } else {
      XB_SPIN(xb_ld(&bar[XB_XGEN(b.x)]) == gen, bar);
      __builtin_amdgcn_fence(__ATOMIC_ACQUIRE, "agent");
      asm volatile("s_waitcnt vmcnt(0)" ::: "memory");
    }
  }
  __syncthreads();
}
constexpr size_t OFF_XBAR = OFF_MISC + 16384;

#ifndef PH_MASK
#define PH_MASK 0x3ff
#endif
#define PH_ON(n) (((PH_MASK) >> (n)) & 1)
constexpr int SMEM_BYTES = 69632;
__global__ void __launch_bounds__(256, 2) mega(P p) {
  __shared__ __attribute__((aligned(16))) char smem[SMEM_BYTES];
  __shared__ int s_item;
  cg::grid_group grid = cg::this_grid();
  __shared__ __attribute__((aligned(16))) unsigned xb_words[4];
  if (threadIdx.x < 4) xb_words[threadIdx.x] = 0u;
  __syncthreads();
  const XcdBarrier xb = xcd_barrier_post((unsigned*)(p.ws + OFF_XBAR), (volatile LAS unsigned*)&xb_words);
  bf16_t* sA = (bf16_t*)smem;
  bf16_t* sB = (bf16_t*)(smem + 128 * LDT * 2);
  const int lo = p.phase_lo, hi = p.phase_hi;
#define PH_RUN(n) (PH_ON(n) && lo <= (n) && (n) <= hi)
#ifndef PROBE_PHASE
#define PROBE_PHASE -1
#endif
#ifndef PROBE_PHASE2
#define PROBE_PHASE2 -5
#endif
#define PH_SYNC(n) if (lo <= (n) && (n) < hi) { xcd_barrier(xb); } \
  if (PROBE_PHASE >= 0 && blockIdx.x == 0 && threadIdx.x == 0) { \
    if ((n) == PROBE_PHASE - 1) ((unsigned long long*)(p.ws + OFF_MISC))[16] = __builtin_amdgcn_s_memrealtime(); \
    if ((n) == PROBE_PHASE) ((unsigned long long*)(p.ws + OFF_MISC))[17] = __builtin_amdgcn_s_memrealtime(); \
    if ((n) == PROBE_PHASE2 - 1) ((unsigned long long*)(p.ws + OFF_MISC))[18] = __builtin_amdgcn_s_memrealtime(); \
    if ((n) == PROBE_PHASE2) ((unsigned long long*)(p.ws + OFF_MISC))[19] = __builtin_amdgcn_s_memrealtime(); }
  if (PROBE_PHASE == 0 && blockIdx.x == 0 && threadIdx.x == 0) ((unsigned long long*)(p.ws + OFF_MISC))[16] = __builtin_amdgcn_s_memrealtime();
  if (lo > 1000) grid.sync();
  if (PH_RUN(0)) phase0(p);
  PH_SYNC(0)
  if (PH_RUN(1)) {
    for (int t = blockIdx.x; t < N_INPROJ_TILES + N_MEMKV_TILES; t += gridDim.x) phase1_tile(p, t, sA, sB);
  }
  PH_SYNC(1)
  if (PH_RUN(2)) {
    const int qx = blockIdx.x & 7;
    unsigned* ctr = (unsigned*)(p.ws + OFF_MISC) + 16 + qx;
    while (true) {
      __syncthreads();
      if (threadIdx.x == 0) s_item = (int)atomicAdd(ctr, 1u);
      __syncthreads();
      const int li = __builtin_amdgcn_readfirstlane(s_item);
      if (li >= 1536) break;
      const int kind = li >> 9, idx = li & 511, bh = 4 * qx + (idx & 3);
      phase2_item(p, kind * 4096 + (idx >> 2) * 32 + bh, smem);
    }
  }
  PH_SYNC(2)
  if (PH_RUN(3)) gla_scan(p);
  PH_SYNC(3)
  if (PH_RUN(4)) {
    for (int it = blockIdx.x; it < 4096; it += gridDim.x) gla_out_item(p, it, smem);
  }
  PH_SYNC(4)
  if (PH_RUN(5)) {
    for (int t = blockIdx.x; t < 4096; t += gridDim.x) phase5_tile(p, t, sA, sB, (u32x2*)(smem + 36864));
  }
  PH_SYNC(5)
  if (PH_RUN(6)) {
    for (int t = blockIdx.x; t < 4096; t += gridDim.x) phase6_tile(p, t, sA, sB);
  }
  PH_SYNC(6)
  if (PH_RUN(8)) {
    for (int it = blockIdx.x; it < 4096; it += gridDim.x) peer_topk_item(p, it, smem);
  }
  PH_SYNC(8)
  if (PH_RUN(9)) peer_eval(p);
  if (PROBE_PHASE != -1) {
    grid.sync();
    if (PROBE_PHASE == 9) {
      if (blockIdx.x == 0 && threadIdx.x == 0) { ((unsigned long long*)(p.ws + OFF_MISC))[17] = __builtin_amdgcn_s_memrealtime(); __threadfence(); }
      grid.sync();
    }
    const unsigned long long* tt = (const unsigned long long*)(p.ws + OFF_MISC);
    float delta = 0.1f;
    if (PROBE_PHASE >= 0) delta = (float)(tt[17] - tt[16]) * (1e-5f / 40.f);
    const long gtid = (long)blockIdx.x * blockDim.x + threadIdx.x, gstride = (long)gridDim.x * blockDim.x;
    for (long t = gtid; t < T_; t += gstride) p.out[t * 1024] += delta;
    if (PROBE_PHASE2 >= 0 && gtid < 16) p.out[gtid * 1024 + 1] += 0.14f + (float)(tt[19] - tt[18]) * (1e-5f * 0.05f);
  }
}

extern "C" void kernel_launch(void* const* d_in, const int* in_sizes, int n_in, void* d_out, int out_size, void* d_ws, size_t ws_size, hipStream_t stream) {
  static int grid_blocks = 0;
  if (!grid_blocks) {
    int dev = 0, cus = 0, per_cu = 0;
    hipGetDevice(&dev);
    hipDeviceGetAttribute(&cus, hipDeviceAttributeMultiprocessorCount, dev);
    hipOccupancyMaxActiveBlocksPerMultiprocessor(&per_cu, mega, 256, 0);
    if (per_cu < 1) per_cu = 1;
    if (per_cu > 2) per_cu = 2;
    grid_blocks = cus * per_cu;
  }
  P p{};
  const float** f = (const float**)&p;
  for (int i = 0; i < 24; i++) f[i] = (const float*)d_in[i];
  p.out = (float*)d_out;
  p.ws = (char*)d_ws;
  p.phase_lo = 0;
  p.phase_hi = 9;
  hipMemsetAsync((char*)d_ws + OFF_XBAR, 0, XCD_BAR_WORDS * sizeof(unsigned), stream);
  void* args[] = {&p};
  hipError_t e = hipLaunchCooperativeKernel((void*)mega, dim3(grid_blocks), dim3(256), args, 0, stream);
  if (e != hipSuccess) fprintf(stderr, "cooperative launch failed: %s (grid %d)\n", hipGetErrorString(e), grid_blocks);
}
```

```cpp
#include <hip/hip_runtime.h>
#include <hip/hip_cooperative_groups.h>
#include <cstdio>
namespace cg = cooperative_groups;

#define DI __device__ __forceinline__
typedef unsigned short bf16_t;
typedef short bf16x8 __attribute__((ext_vector_type(8)));
typedef short s16x4 __attribute__((ext_vector_type(4)));
typedef float f32x4 __attribute__((ext_vector_type(4)));
typedef unsigned u32x4 __attribute__((ext_vector_type(4)));
typedef unsigned u32x2 __attribute__((ext_vector_type(2)));
typedef __bf16 bf2_t __attribute__((ext_vector_type(2)));

constexpr int T_ = 65536, S_ = 8192;
constexpr float EPS = 1e-6f;
constexpr float LOG2E = 1.4426950408889634f;
constexpr size_t MiB = 1ull << 20;
constexpr size_t OFF_WIN = 0, OFF_WG = 8 * MiB, OFF_WMEM = 14 * MiB, OFF_WBR = 16 * MiB, OFF_WOUT = 20 * MiB, OFF_WQ = 22 * MiB,
                 OFF_SUBK = 26 * MiB, OFF_MISC = 27 * MiB, OFF_MEMN = 28 * MiB, OFF_MK = 32 * MiB, OFF_MVT = 34 * MiB, OFF_GLG = 36 * MiB,
                 OFF_DEC = 40 * MiB, OFF_U = 48 * MiB, OFF_V = 80 * MiB, OFF_DAQ = 112 * MiB, OFF_DAK = 176 * MiB, OFF_DAVT = 240 * MiB,
                 OFF_GLQ = 304 * MiB, OFF_GLK = 336 * MiB, OFF_GLV = 368 * MiB, OFF_GLR = 432 * MiB, OFF_XAQ = 496 * MiB, OFF_MERGED = 560 * MiB;
constexpr size_t OFF_ROWSS = OFF_MISC + 512 * 1024;
constexpr size_t OFF_SU = OFF_MISC + 128 * 1024, OFF_SV = OFF_MISC + 256 * 1024;
constexpr size_t OFF_XN2 = OFF_DAK, OFF_PIDX = OFF_GLQ, OFF_PG = OFF_GLK;
constexpr size_t OUT_XN = 0, OUT_ST = 128 * MiB;

struct P {
  const float *x, *mem, *mix_norm_w, *w_in, *da_q_norm_w, *da_k_norm_w, *da_lambda, *da_out_norm_w, *gla_w_gate, *gla_b_gate,
      *gla_out_norm_w, *mem_norm_w, *w_mem_kv, *xa_q_norm_w, *xa_k_norm_w, *w_br_da, *w_br_gla, *w_br_xa, *w_out, *ffn_norm_w,
      *peer_w_q, *peer_sub_keys, *peer_u, *peer_v;
  float* out;
  char* ws;
  int phase_lo, phase_hi;
};

DI bf16_t f2bf(float f) { unsigned u = __float_as_uint(f); u += 0x7fffu + ((u >> 16) & 1u); return (bf16_t)(u >> 16); }
DI float bf2f(bf16_t h) { return __uint_as_float(((unsigned)h) << 16); }
typedef float f32x2_ __attribute__((ext_vector_type(2)));
typedef __bf16 bf16x2_ __attribute__((ext_vector_type(2)));
DI unsigned pack2(float a, float b) { return __builtin_bit_cast(unsigned, __builtin_convertvector(f32x2_{a, b}, bf16x2_)); }
DI bf16x8 pack8_mfma(float a0, float a1, float a2, float a3, float a4, float a5, float a6, float a7) {
  return __builtin_bit_cast(bf16x8, u32x4{pack2(a0, a1), pack2(a2, a3), pack2(a4, a5), pack2(a6, a7)});
}
DI float lo2f(unsigned u) { return __uint_as_float(u << 16); }
DI float hi2f(unsigned u) { return __uint_as_float(u & 0xffff0000u); }
DI f32x4 mfma16(bf16x8 a, bf16x8 b, f32x4 c) { return __builtin_amdgcn_mfma_f32_16x16x32_bf16(a, b, c, 0, 0, 0); }
DI float fexp2(float x) { return __builtin_amdgcn_exp2f(x); }
DI float frcp(float x) { return __builtin_amdgcn_rcpf(x); }
DI void glds16(const void* g, unsigned lds_base) {
  unsigned sv;
  asm volatile("s_mov_b32 %0, m0\n\ts_mov_b32 m0, %2\n\ts_nop 0\n\tglobal_load_lds_dwordx4 %1, off\n\ts_mov_b32 m0, %0" : "=&s"(sv) : "v"(g), "s"(lds_base) : "memory");
}
DI unsigned lds_addr(const void* p) { return (unsigned)(size_t)p; }
DI float xor16(float v) { return __shfl_xor(v, 16); }
DI float xor32(float v) { return __shfl_xor(v, 32); }
DI float quadsum(float v) { v += __shfl_xor(v, 16); v += __shfl_xor(v, 32); return v; }
DI float quadmax(float v) { v = fmaxf(v, __shfl_xor(v, 16)); v = fmaxf(v, __shfl_xor(v, 32)); return v; }
DI float wavesum(float v) {
#pragma unroll
  for (int o = 32; o > 0; o >>= 1) v += __shfl_xor(v, o);
  return v;
}

constexpr int LDT = 72;
#define RAW_BARRIER() do { asm volatile("s_waitcnt lgkmcnt(0)" ::: "memory"); __builtin_amdgcn_s_barrier(); } while (0)
template <int BK, int STAGES>
DI void gemm_tile(const bf16_t* __restrict__ A, long lda, const bf16_t* __restrict__ Bt, long ldb, int K, f32x4 (&acc)[2][8], char* sbuf) {
  const int tid = threadIdx.x, lane = tid & 63, w = tid >> 6, r16 = lane & 15, quad = lane >> 4;
  const int wu = __builtin_amdgcn_readfirstlane(w);
  constexpr int CH = BK / 8, RPI = 64 / CH, NI = 128 / RPI / 4, TILE_B = 128 * BK * 2, STAGE_B = 2 * TILE_B;
  auto issue = [&](int kt_, int st) {
#pragma unroll
    for (int i = 0; i < NI; i++) {
      const int j = wu + 4 * i;
      const int row = RPI * j + lane / CH, pp = lane % CH;
      const int c = pp ^ (BK == 32 ? ((row >> 2) & 3) : ((row >> 1) & 7));
      glds16(A + (long)row * lda + kt_ * BK + c * 8, __builtin_amdgcn_readfirstlane(lds_addr(sbuf + st * STAGE_B + j * 1024)));
      glds16(Bt + (long)row * ldb + kt_ * BK + c * 8, __builtin_amdgcn_readfirstlane(lds_addr(sbuf + st * STAGE_B + TILE_B + j * 1024)));
    }
  };
  const int nk = K / BK;
  __syncthreads();
#pragma unroll
  for (int s_ = 0; s_ < STAGES - 1; s_++) issue(s_, s_);
  const int swz = BK == 32 ? ((r16 >> 2) & 3) : ((r16 >> 1) & 7);
#pragma unroll 1
  for (int kt = 0; kt < nk; kt++) {
    if (STAGES == 2 || kt + STAGES - 2 >= nk) {
      asm volatile("s_waitcnt vmcnt(0)" ::: "memory");
    } else {
      if (NI == 2) asm volatile("s_waitcnt vmcnt(4)" ::: "memory");
      else asm volatile("s_waitcnt vmcnt(8)" ::: "memory");
    }
    RAW_BARRIER();
    if (kt + STAGES - 1 < nk) issue(kt + STAGES - 1, (kt + STAGES - 1) % STAGES);
    const bf16_t* sA = (const bf16_t*)(sbuf + (kt % STAGES) * STAGE_B);
    const bf16_t* sB = (const bf16_t*)(sbuf + (kt % STAGES) * STAGE_B + TILE_B);
#pragma unroll
    for (int ks = 0; ks < BK / 32; ks++) {
      bf16x8 af[2];
#pragma unroll
      for (int mt = 0; mt < 2; mt++) af[mt] = *(const bf16x8*)(sA + (32 * w + 16 * mt + r16) * BK + (((ks * 4 + quad) ^ swz) * 8));
#pragma unroll
      for (int nt = 0; nt < 8; nt++) {
        bf16x8 bfr = *(const bf16x8*)(sB + (16 * nt + r16) * BK + (((ks * 4 + quad) ^ swz) * 8));
#pragma unroll
        for (int mt = 0; mt < 2; mt++) acc[mt][nt] = mfma16(bfr, af[mt], acc[mt][nt]);
      }
    }
  }
}
DI void zero_acc(f32x4 (&acc)[2][8]) {
#pragma unroll
  for (int a = 0; a < 2; a++)
#pragma unroll
    for (int b = 0; b < 8; b++) acc[a][b] = f32x4{0.f, 0.f, 0.f, 0.f};
}

DI void transpose_convert(const float* __restrict__ src, int ldsrc, int col0, bf16_t* __restrict__ dst, int K, int n0, int ncols, long gtid, long gstride) {
  const long total = (long)ncols * (K / 8);
  for (long idx = gtid; idx < total; idx += gstride) {
    const int n = (int)(idx % ncols), kc = (int)(idx / ncols);
    unsigned pk[4];
#pragma unroll
    for (int j = 0; j < 4; j++) {
      float a = src[(long)(kc * 8 + 2 * j) * ldsrc + col0 + n];
      float b = src[(long)(kc * 8 + 2 * j + 1) * ldsrc + col0 + n];
      pk[j] = pack2(a, b);
    }
    *(u32x4*)(dst + (long)(n0 + n) * K + kc * 8) = u32x4{pk[0], pk[1], pk[2], pk[3]};
  }
}
DI void convert_flat(const float* __restrict__ src, bf16_t* __restrict__ dst, long n, long gtid, long gstride) {
  for (long i = gtid; i < n / 8; i += gstride) {
    f32x4 a = ((const f32x4*)src)[2 * i], b = ((const f32x4*)src)[2 * i + 1];
    ((u32x4*)dst)[i] = u32x4{pack2(a.x, a.y), pack2(a.z, a.w), pack2(b.x, b.y), pack2(b.z, b.w)};
  }
}
DI void rmsnorm_rows(const float* __restrict__ src, const float* __restrict__ w, bf16_t* __restrict__ dst, int nrows, int gwave, int nwaves) {
  const int lane = threadIdx.x & 63;
  for (int r = gwave; r < nrows; r += nwaves) {
    const f32x4* s4 = (const f32x4*)(src + (long)r * 1024);
    f32x4 v[4];
    float ss = 0.f;
#pragma unroll
    for (int j = 0; j < 4; j++) { v[j] = s4[j * 64 + lane]; ss += v[j].x * v[j].x + v[j].y * v[j].y + v[j].z * v[j].z + v[j].w * v[j].w; }
    ss = wavesum(ss);
    const float rstd = rsqrtf(ss * (1.f / 1024.f) + EPS);
#pragma unroll
    for (int j = 0; j < 4; j++) {
      f32x4 ww = ((const f32x4*)w)[j * 64 + lane];
      u32x2 o = u32x2{pack2(v[j].x * rstd * ww.x, v[j].y * rstd * ww.y), pack2(v[j].z * rstd * ww.z, v[j].w * rstd * ww.w)};
      *(u32x2*)(dst + (long)r * 1024 + (j * 64 + lane) * 4) = o;
    }
  }
}

DI void quant_rows_fp8(const float* __restrict__ src, unsigned* __restrict__ dst, float* __restrict__ scales, int nrows, int gwave, int nwaves) {
  const int lane = threadIdx.x & 63;
  for (int r = gwave; r < nrows; r += nwaves) {
    const f32x4* s4 = (const f32x4*)(src + (long)r * 1024 + lane * 16);
    f32x4 v[4];
    float am = 0.f;
#pragma unroll
    for (int j = 0; j < 4; j++) {
      v[j] = s4[j];
      am = fmaxf(am, fmaxf(fmaxf(fabsf(v[j].x), fabsf(v[j].y)), fmaxf(fabsf(v[j].z), fabsf(v[j].w))));
    }
#pragma unroll
    for (int o = 32; o > 0; o >>= 1) am = fmaxf(am, __shfl_xor(am, o));
    const float sc = am > 0.f ? am * (1.f / 448.f) : 1.f;
    const float inv = 1.f / sc;
    u32x4 o4;
#pragma unroll
    for (int j = 0; j < 4; j++) {
      int w_ = __builtin_amdgcn_cvt_pk_fp8_f32(v[j].x * inv, v[j].y * inv, 0, false);
      w_ = __builtin_amdgcn_cvt_pk_fp8_f32(v[j].z * inv, v[j].w * inv, w_, true);
      o4[j] = (unsigned)w_;
    }
    *(u32x4*)(dst + (long)r * 256 + lane * 4) = o4;
    if (lane == 0) scales[r] = sc;
  }
}

DI void quant_rows_fp6(const float* __restrict__ src, unsigned* __restrict__ dst, float* __restrict__ scales, int nrows, int gwave, int nwaves);
DI void phase0(const P& p) {
  const long gtid = (long)blockIdx.x * blockDim.x + threadIdx.x, gstride = (long)gridDim.x * blockDim.x;
  char* ws = p.ws;
  bf16_t* win = (bf16_t*)(ws + OFF_WIN);
  transpose_convert(p.w_in, 6672, 0, win, 1024, 0, 3072, gtid, gstride);
  transpose_convert(p.w_in, 6672, 3088, win, 1024, 3072, 512, gtid, gstride);
  transpose_convert(p.w_in, 6672, 3072, win, 1024, 3584, 16, gtid, gstride);
  for (long i = gtid; i < 112 * 1024 / 8; i += gstride) ((u32x4*)(win + 3600 * 1024))[i] = u32x4{0, 0, 0, 0};
  transpose_convert(p.w_in, 6672, 3600, (bf16_t*)(ws + OFF_WG), 1024, 0, 3072, gtid, gstride);
  transpose_convert(p.w_mem_kv, 1024, 0, (bf16_t*)(ws + OFF_WMEM), 1024, 0, 1024, gtid, gstride);
  transpose_convert(p.w_br_da, 1024, 0, (bf16_t*)(ws + OFF_WBR), 512, 0, 1024, gtid, gstride);
  transpose_convert(p.w_br_gla, 1024, 0, (bf16_t*)(ws + OFF_WBR + MiB), 512, 0, 1024, gtid, gstride);
  transpose_convert(p.w_br_xa, 1024, 0, (bf16_t*)(ws + OFF_WBR + 2 * MiB), 512, 0, 1024, gtid, gstride);
  transpose_convert(p.w_out, 1024, 0, (bf16_t*)(ws + OFF_WOUT), 1024, 0, 1024, gtid, gstride);
  transpose_convert(p.peer_w_q, 2048, 0, (bf16_t*)(ws + OFF_WQ), 1024, 0, 2048, gtid, gstride);
  convert_flat(p.peer_sub_keys, (bf16_t*)(ws + OFF_SUBK), 2 * 128 * 128, gtid, gstride);
  for (long i = gtid; i < T_; i += gstride) ((float*)(ws + OFF_ROWSS))[i] = 0.f;
  const int gwave = (int)(gtid >> 6), nwaves = (int)(gstride >> 6);
  quant_rows_fp6(p.peer_u, (unsigned*)(ws + OFF_U), (float*)(ws + OFF_SU), 16384, gwave, nwaves);
  quant_rows_fp6(p.peer_v, (unsigned*)(ws + OFF_V), (float*)(ws + OFF_SV), 16384, gwave, nwaves);
  rmsnorm_rows(p.x, p.mix_norm_w, (bf16_t*)((char*)p.out + OUT_XN), T_, gwave, nwaves);
  rmsnorm_rows(p.mem, p.mem_norm_w, (bf16_t*)(ws + OFF_MEMN), 2048, gwave, nwaves);
  if (gtid == 0) {
    float s0 = 0.f, s1 = 0.f;
    for (int i = 0; i < 64; i++) { s0 += p.da_lambda[i] * p.da_lambda[64 + i]; s1 += p.da_lambda[128 + i] * p.da_lambda[192 + i]; }
    float* misc = (float*)(ws + OFF_MISC);
    misc[0] = expf(s0) - expf(s1) + 0.2f;
    float mq = 0.f, mk = 0.f;
    for (int i = 0; i < 64; i++) { mq = fmaxf(mq, fabsf(p.da_q_norm_w[i])); mk = fmaxf(mk, fabsf(p.da_k_norm_w[i])); }
    misc[1] = 8.f * LOG2E * mq * mk * 1.001f;
    for (int i = 0; i < 8; i++) ((unsigned*)misc)[16 + i] = 0u;
  }
}

constexpr int NT_IN = 29, N_INPROJ_TILES = 512 * NT_IN, N_MEMKV_TILES = 16 * 8;

template <int GS>
DI void epi_norm_store(const f32x4 (&acc)[2][8], const float* __restrict__ w, float scale, bf16_t* __restrict__ dst, long ldd, int w_, int r16, int quad) {
#pragma unroll
  for (int mt = 0; mt < 2; mt++) {
    const int m = 32 * w_ + 16 * mt + r16;
#pragma unroll
    for (int g = 0; g < 128 / GS; g++) {
      float ss = 0.f;
#pragma unroll
      for (int nt = g * (GS / 16); nt < (g + 1) * (GS / 16); nt++)
#pragma unroll
        for (int i = 0; i < 4; i++) ss += acc[mt][nt][i] * acc[mt][nt][i];
      ss = quadsum(ss);
      const float rs = rsqrtf(ss * (1.f / GS) + EPS) * scale;
#pragma unroll
      for (int nt = g * (GS / 16); nt < (g + 1) * (GS / 16); nt++) {
        const int col = 16 * nt + 4 * quad;
        const f32x4 ww = *(const f32x4*)(w + (col & (GS - 1)));
        u32x2 o = u32x2{pack2(acc[mt][nt][0] * rs * ww.x, acc[mt][nt][1] * rs * ww.y), pack2(acc[mt][nt][2] * rs * ww.z, acc[mt][nt][3] * rs * ww.w)};
        *(u32x2*)(dst + (long)m * ldd + col) = o;
      }
    }
  }
}
DI void epi_plain_store(const f32x4 (&acc)[2][8], float scale, bf16_t* __restrict__ dst, long ldd, int w_, int r16, int quad) {
#pragma unroll
  for (int mt = 0; mt < 2; mt++) {
    const int m = 32 * w_ + 16 * mt + r16;
#pragma unroll
    for (int nt = 0; nt < 8; nt++) {
      const int col = 16 * nt + 4 * quad;
      u32x2 o = u32x2{pack2(acc[mt][nt][0] * scale, acc[mt][nt][1] * scale), pack2(acc[mt][nt][2] * scale, acc[mt][nt][3] * scale)};
      *(u32x2*)(dst + (long)m * ldd + col) = o;
    }
  }
}
DI void epi_trans_store(const f32x4 (&acc)[2][8], bf16_t* __restrict__ dst, long ldd, int w_, int r16, int quad, bf16_t* sT) {
  __syncthreads();
#pragma unroll
  for (int mt = 0; mt < 2; mt++) {
    const int m = 32 * w_ + 16 * mt + r16;
#pragma unroll
    for (int nt = 0; nt < 8; nt++)
#pragma unroll
      for (int i = 0; i < 4; i++) sT[(16 * nt + 4 * quad + i) * 136 + m] = f2bf(acc[mt][nt][i]);
  }
  __syncthreads();
  const int tid = threadIdx.x;
#pragma unroll
  for (int i = 0; i < 8; i++) {
    const int c = tid + 256 * i, n = c >> 4, mc = (c & 15) * 8;
    *(u32x4*)(dst + (long)n * ldd + mc) = *(const u32x4*)(sT + n * 136 + mc);
  }
}

DI void phase1_tile(const P& p, int tile, bf16_t* sA, bf16_t* sB) {
  const int tid = threadIdx.x, lane = tid & 63, w = tid >> 6, r16 = lane & 15, quad = lane >> 4;
  char* ws = p.ws;
  f32x4 acc[2][8];
  zero_acc(acc);
  if (tile < N_INPROJ_TILES) {
    const int xcd = tile & 7, j = tile >> 3;
    int ng = j / (64 * 8), rem = j - ng * 64 * 8, gsz = 8;
    if (ng >= 3) { ng = 3; rem = j - 3 * 64 * 8; gsz = 5; }
    const int mp = (rem / gsz) * 8 + xcd, nt_ = ng * 8 + rem % gsz;
    const bf16_t* A = (const bf16_t*)((const char*)p.out + OUT_XN) + (long)mp * 128 * 1024;
    const bf16_t* Bt = (const bf16_t*)(ws + OFF_WIN) + (long)nt_ * 128 * 1024;
    gemm_tile<64, 2>(A, 1024, Bt, 1024, 1024, acc, (char*)sA);
    const long m0 = (long)mp * 128;
    if (nt_ < 4) {
      epi_norm_store<64>(acc, p.da_q_norm_w, 0.125f * LOG2E, (bf16_t*)(ws + OFF_DAQ) + m0 * 512 + nt_ * 128, 512, w, r16, quad);
    } else if (nt_ < 8) {
      epi_norm_store<64>(acc, p.da_k_norm_w, 1.f, (bf16_t*)(ws + OFF_DAK) + m0 * 512 + (nt_ - 4) * 128, 512, w, r16, quad);
    } else if (nt_ < 12) {
      const int b = (int)(m0 / S_), s0 = (int)(m0 % S_), h = nt_ - 8;
      epi_trans_store(acc, (bf16_t*)(ws + OFF_DAVT) + ((long)(b * 4 + h) * 128) * S_ + s0, S_, w, r16, quad, sA);
    } else if (nt_ < 14) {
      epi_plain_store(acc, 0.125f, (bf16_t*)(ws + OFF_GLQ) + m0 * 256 + (nt_ - 12) * 128, 256, w, r16, quad);
    } else if (nt_ < 16) {
      epi_plain_store(acc, 1.f, (bf16_t*)(ws + OFF_GLK) + m0 * 256 + (nt_ - 14) * 128, 256, w, r16, quad);
    } else if (nt_ < 20) {
      epi_plain_store(acc, 1.f, (bf16_t*)(ws + OFF_GLV) + m0 * 512 + (nt_ - 16) * 128, 512, w, r16, quad);
    } else if (nt_ < 24) {
      epi_plain_store(acc, 1.f, (bf16_t*)(ws + OFF_GLR) + m0 * 512 + (nt_ - 20) * 128, 512, w, r16, quad);
    } else if (nt_ < 28) {
      epi_norm_store<128>(acc, p.xa_q_norm_w, 0.08838834764831845f * LOG2E, (bf16_t*)(ws + OFF_XAQ) + m0 * 512 + (nt_ - 24) * 128, 512, w, r16, quad);
    } else {
      float* glg = (float*)(ws + OFF_GLG);
#pragma unroll
      for (int mt = 0; mt < 2; mt++) {
        const long m = m0 + 32 * w + 16 * mt + r16;
        *(f32x4*)(glg + m * 16 + 4 * quad) = acc[mt][0];
      }
    }
  } else {
    const int t2 = tile - N_INPROJ_TILES, mp = t2 >> 3, nt_ = t2 & 7;
    const bf16_t* A = (const bf16_t*)(ws + OFF_MEMN) + (long)mp * 128 * 1024;
    const bf16_t* Bt = (const bf16_t*)(ws + OFF_WMEM) + (long)nt_ * 128 * 1024;
    gemm_tile<64, 2>(A, 1024, Bt, 1024, 1024, acc, (char*)sA);
    const long m0 = (long)mp * 128;
    if (nt_ < 4) {
      epi_norm_store<128>(acc, p.xa_k_norm_w, 1.f, (bf16_t*)(ws + OFF_MK) + m0 * 512 + nt_ * 128, 512, w, r16, quad);
    } else {
      const int b = (int)(m0 / 256), mm0 = (int)(m0 % 256), h = nt_ - 4;
      epi_trans_store(acc, (bf16_t*)(ws + OFF_MVT) + ((long)(b * 4 + h) * 128) * 256 + mm0, 256, w, r16, quad, sA);
    }
  }
}

constexpr int LDK = 136, LDV = 72;
template <int DQK, int NCOMP, bool CAUSAL, bool NORM, bool FIXM>
DI void attn_item(const bf16_t* __restrict__ Q, int ldq, const bf16_t* __restrict__ Kp, int ldk, const bf16_t* __restrict__ VT, int ldv, int ntiles, int q0,
                  float slope2, float lam, const float* __restrict__ normw, float outscale, bf16_t* __restrict__ O, int ldo, bf16_t* sK, bf16_t* sV, float mfix) {
  const int tid = threadIdx.x, lane = tid & 63, w = tid >> 6, r16 = lane & 15, quad = lane >> 4;
  constexpr int KS = DQK / 32;
  bf16x8 qf[NCOMP][KS];
#pragma unroll
  for (int c = 0; c < NCOMP; c++)
#pragma unroll
    for (int ks = 0; ks < KS; ks++) qf[c][ks] = *(const bf16x8*)(Q + (long)(16 * w + r16) * ldq + c * DQK + ks * 32 + quad * 8);
  f32x4 oacc[NCOMP][8];
  float mrun[NCOMP], lrun[NCOMP];
#pragma unroll
  for (int c = 0; c < NCOMP; c++) {
    mrun[c] = -1e30f; lrun[c] = 0.f;
#pragma unroll
    for (int et = 0; et < 8; et++) oacc[c][et] = f32x4{0.f, 0.f, 0.f, 0.f};
  }
  const int tq = q0 + 16 * w + r16;
  const int wu = __builtin_amdgcn_readfirstlane(w);
  char* const sbase = (char*)sK;
  auto issue_tile = [&](int kt_, int buf) {
    const int k1 = kt_ * 64;
    char* kb = sbase + buf * 32768;
    char* vb = kb + 16384;
#pragma unroll
    for (int j = 0; j < 4; j++) {
      const int rk_ = 4 * j + (lane >> 4);
      const bf16_t* gk = Kp + (long)(k1 + 16 * wu + rk_) * ldk + (((lane & 15) ^ rk_) * 8);
      glds16(gk, __builtin_amdgcn_readfirstlane(lds_addr(kb + (16 * wu + 4 * j) * 256)));
      const int rv_ = 32 * wu + 8 * j + (lane >> 3);
      const bf16_t* gv = VT + (long)rv_ * ldv + k1 + (((lane & 7) ^ ((rv_ >> 1) & 7)) * 8);
      glds16(gv, __builtin_amdgcn_readfirstlane(lds_addr(vb + (32 * wu + 8 * j) * 128)));
    }
  };
  issue_tile(0, 0);
  const int vsw = (r16 >> 1) & 7;
#pragma unroll 1
  for (int kt = 0; kt < ntiles; kt++) {
    asm volatile("s_waitcnt vmcnt(0)" ::: "memory");
    __syncthreads();
    if (kt + 1 < ntiles) issue_tile(kt + 1, (kt + 1) & 1);
    const bf16_t* sKb = (const bf16_t*)(sbase + (kt & 1) * 32768);
    const bf16_t* sVb = (const bf16_t*)(sbase + (kt & 1) * 32768 + 16384);
    __builtin_amdgcn_sched_barrier(0);
    const int k0 = kt * 64;
    if (CAUSAL && k0 > q0 + 16 * w + 15) continue;
    const bool diag = CAUSAL && (k0 + 63 > q0 + 16 * w);
    const float base_t = (CAUSAL ? slope2 * (float)(k0 + 4 * quad - tq) : 0.f) - (FIXM ? mfix : 0.f);
    bf16x8 pf[NCOMP][2];
#pragma unroll
    for (int c = 0; c < NCOMP; c++) {
      f32x4 s[4];
#pragma unroll
      for (int mt = 0; mt < 4; mt++) {
        if (CAUSAL) {
#pragma unroll
          for (int i = 0; i < 4; i++) s[mt][i] = fmaf(slope2, (float)(16 * mt + i), base_t);
        } else {
          s[mt] = f32x4{base_t, base_t, base_t, base_t};
        }
      }
#pragma unroll
      for (int ks = 0; ks < KS; ks++)
#pragma unroll
        for (int mt = 0; mt < 4; mt++) {
          bf16x8 kf = *(const bf16x8*)(sKb + (16 * mt + r16) * 128 + (((c * DQK / 8 + ks * 4 + quad) ^ r16) * 8));
          s[mt] = mfma16(kf, qf[c][ks], s[mt]);
        }
      if (diag) {
#pragma unroll
        for (int mt = 0; mt < 4; mt++)
#pragma unroll
          for (int i = 0; i < 4; i++)
            if (k0 + 16 * mt + 4 * quad + i > tq) s[mt][i] = -1e30f;
      }
      float mref = 0.f;
      if (!FIXM) {
        float mx = -1e30f;
#pragma unroll
        for (int mt = 0; mt < 4; mt++)
#pragma unroll
          for (int i = 0; i < 4; i++) mx = fmaxf(mx, s[mt][i]);
        mx = quadmax(mx);
        const float mnew = fmaxf(mrun[c], mx);
        const float alpha = fexp2(mrun[c] - mnew);
        mrun[c] = mnew;
        lrun[c] *= alpha;
#pragma unroll
        for (int et = 0; et < 8; et++) oacc[c][et] *= alpha;
        mref = mnew;
      }
      float ls = 0.f;
#pragma unroll
      for (int mt = 0; mt < 4; mt++)
#pragma unroll
        for (int i = 0; i < 4; i++) { s[mt][i] = fexp2(FIXM ? s[mt][i] : s[mt][i] - mref); ls += s[mt][i]; }
      lrun[c] += ls;
#pragma unroll
      for (int ks2 = 0; ks2 < 2; ks2++)
        pf[c][ks2] = pack8_mfma(s[2 * ks2][0], s[2 * ks2][1], s[2 * ks2][2], s[2 * ks2][3], s[2 * ks2 + 1][0], s[2 * ks2 + 1][1], s[2 * ks2 + 1][2], s[2 * ks2 + 1][3]);
    }
    __builtin_amdgcn_sched_barrier(0);
#pragma unroll
    for (int ks2 = 0; ks2 < 2; ks2++) {
#pragma unroll
      for (int et = 0; et < 8; et++) {
        const bf16_t* vrow_ = sVb + (16 * et + r16) * 64 + (quad & 1) * 4;
        s16x4 lo = *(const s16x4*)(vrow_ + (((4 * ks2 + (quad >> 1)) ^ vsw) * 8)), hi = *(const s16x4*)(vrow_ + (((4 * ks2 + 2 + (quad >> 1)) ^ vsw) * 8));
        bf16x8 vf = __builtin_shufflevector(lo, hi, 0, 1, 2, 3, 4, 5, 6, 7);
#pragma unroll
        for (int c = 0; c < NCOMP; c++) oacc[c][et] = mfma16(vf, pf[c][ks2], oacc[c][et]);
      }
    }
    __builtin_amdgcn_sched_barrier(0);
  }
  float inv[NCOMP];
#pragma unroll
  for (int c = 0; c < NCOMP; c++) inv[c] = 1.f / quadsum(lrun[c]);
  f32x4 o[8];
  float ss = 0.f;
#pragma unroll
  for (int et = 0; et < 8; et++) {
#pragma unroll
    for (int i = 0; i < 4; i++) {
      float v = oacc[0][et][i] * inv[0];
      if (NCOMP == 2) v -= lam * oacc[NCOMP - 1][et][i] * inv[NCOMP - 1];
      o[et][i] = v;
      ss += v * v;
    }
  }
  float rs = 1.f;
  if (NORM) { ss = quadsum(ss); rs = rsqrtf(ss * (1.f / 128.f) + EPS) * outscale; }
#pragma unroll
  for (int et = 0; et < 8; et++) {
    const int e = 16 * et + 4 * quad;
    f32x4 ww = f32x4{1.f, 1.f, 1.f, 1.f};
    if (NORM) ww = *(const f32x4*)(normw + e);
    u32x2 ov = u32x2{pack2(o[et][0] * rs * ww.x, o[et][1] * rs * ww.y), pack2(o[et][2] * rs * ww.z, o[et][3] * rs * ww.w)};
    *(u32x2*)(O + (long)(16 * w + r16) * ldo + e) = ov;
  }
}

DI void gla_compute_b(const P& p, int h, long t0, float (&bl)[16], float& btot, float* sG, float* sTot) {
  const int tid = threadIdx.x, d = tid & 63, seg = tid >> 6;
  const float* glg = (const float*)(p.ws + OFF_GLG) + t0 * 16;
  ((f32x4*)sG)[tid] = ((const f32x4*)glg)[tid];
  float wg[16];
#pragma unroll
  for (int r = 0; r < 16; r++) wg[r] = p.gla_w_gate[r * 256 + h * 64 + d];
  const float bg = p.gla_b_gate[h * 64 + d];
  __syncthreads();
  float run = 0.f;
#pragma unroll
  for (int tt = 0; tt < 16; tt++) {
    const float* g = sG + (seg * 16 + tt) * 16;
    float z = bg;
#pragma unroll
    for (int r = 0; r < 16; r++) z += g[r] * wg[r];
    const float la = (fminf(z, 0.f) - __logf(1.f + __expf(-fabsf(z)))) * (1.f / 16.f);
    run += la;
    bl[tt] = run;
    if ((tt & 3) == 3) __builtin_amdgcn_sched_barrier(0);
  }
  sTot[seg * 64 + d] = run;
  __syncthreads();
  float off = 0.f, tot = 0.f;
#pragma unroll
  for (int s2 = 0; s2 < 4; s2++) { const float v = sTot[s2 * 64 + d]; tot += v; if (s2 < seg) off += v; }
#pragma unroll
  for (int tt = 0; tt < 16; tt++) bl[tt] += off;
  btot = tot;
}
DI void gla_fetch_v(const P& p, int h, long t0, unsigned (&pk)[16]) {
  const int tid = threadIdx.x, e = tid & 127, half = tid >> 7;
  const bf16_t* gv = (const bf16_t*)(p.ws + OFF_GLV) + (t0 + half * 32) * 512 + h * 128 + e;
#pragma unroll
  for (int q = 0; q < 16; q++) {
    const unsigned a = gv[(long)(2 * q) * 512], b = gv[(long)(2 * q + 1) * 512];
    pk[q] = a | (b << 16);
  }
}
DI void gla_store_v(bf16_t* sVT, const unsigned (&pk)[16]) {
  const int tid = threadIdx.x, e = tid & 127, half = tid >> 7;
#pragma unroll
  for (int j = 0; j < 4; j++) *(u32x4*)(sVT + e * LDT + half * 32 + j * 8) = u32x4{pk[4 * j], pk[4 * j + 1], pk[4 * j + 2], pk[4 * j + 3]};
}

DI void gla_local_item(const P& p, int item, char* smem) {
  const int tid = threadIdx.x, lane = tid & 63, w = tid >> 6, r16 = lane & 15, quad = lane >> 4;
  const int bh = item >> 7, c = item & 127, b = bh >> 2, h = bh & 3;
  const long t0 = (long)b * S_ + c * 64;
  bf16_t* sKT = (bf16_t*)smem;
  bf16_t* sVT = (bf16_t*)(smem + 9216);
  float* sG = (float*)(smem + 9216 + 18432);
  float* sTot = (float*)(smem + 9216 + 18432 + 4096);
  __syncthreads();
  const int d = tid & 63, seg = tid >> 6;
  const bf16_t* gk = (const bf16_t*)(p.ws + OFF_GLK) + (t0 + seg * 16) * 256 + h * 64 + d;
  bf16_t kraw[16];
#pragma unroll
  for (int q = 0; q < 16; q++) kraw[q] = gk[(long)q * 256];
  unsigned vpk[16];
  gla_fetch_v(p, h, t0, vpk);
  float bl[16], btot;
  gla_compute_b(p, h, t0, bl, btot, sG, sTot);
  unsigned pk[8];
#pragma unroll
  for (int q = 0; q < 8; q++) {
    const float k0v = bf2f(kraw[2 * q]) * __expf(btot - bl[2 * q]);
    const float k1v = bf2f(kraw[2 * q + 1]) * __expf(btot - bl[2 * q + 1]);
    pk[q] = pack2(k0v, k1v);
  }
  *(u32x4*)(sKT + d * LDT + seg * 16) = u32x4{pk[0], pk[1], pk[2], pk[3]};
  *(u32x4*)(sKT + d * LDT + seg * 16 + 8) = u32x4{pk[4], pk[5], pk[6], pk[7]};
  if (seg == 0) ((float*)(p.ws + OFF_DEC))[(long)item * 64 + d] = __expf(btot);
  gla_store_v(sVT, vpk);
  __syncthreads();
  bf16_t* ST = (bf16_t*)((char*)p.out + OUT_ST) + (long)item * 8192;
#pragma unroll
  for (int n2 = 0; n2 < 2; n2++) {
    const int nt = 2 * w + n2;
    f32x4 acc[4];
#pragma unroll
    for (int mt = 0; mt < 4; mt++) acc[mt] = f32x4{0.f, 0.f, 0.f, 0.f};
#pragma unroll
    for (int ks = 0; ks < 2; ks++) {
      bf16x8 vf = *(const bf16x8*)(sVT + (16 * nt + r16) * LDT + ks * 32 + quad * 8);
#pragma unroll
      for (int mt = 0; mt < 4; mt++) {
        bf16x8 kf = *(const bf16x8*)(sKT + (16 * mt + r16) * LDT + ks * 32 + quad * 8);
        acc[mt] = mfma16(kf, vf, acc[mt]);
      }
    }
#pragma unroll
    for (int mt = 0; mt < 4; mt++) {
      u32x2 o = u32x2{pack2(acc[mt][0], acc[mt][1]), pack2(acc[mt][2], acc[mt][3])};
      *(u32x2*)(ST + (16 * nt + r16) * 64 + 16 * mt + 4 * quad) = o;
    }
  }
}

DI void gla_scan(const P& p) {
  const long gtid = (long)blockIdx.x * blockDim.x + threadIdx.x, gstride = (long)gridDim.x * blockDim.x;
  for (long g = gtid; g < 32 * 2048; g += gstride) {
    const int bh = (int)(g >> 11), eg = (int)(g & 2047), d = (eg * 4) & 63;
    bf16_t* ST = (bf16_t*)((char*)p.out + OUT_ST) + (long)bh * 128 * 8192 + eg * 4;
    const float* DEC = (const float*)(p.ws + OFF_DEC) + (long)bh * 128 * 64 + d;
    float st[4] = {0.f, 0.f, 0.f, 0.f};
#pragma unroll 4
    for (int c = 0; c < 128; c++) {
      const u32x2 loc = *(const u32x2*)(ST + (long)c * 8192);
      const f32x4 dec = *(const f32x4*)(DEC + c * 64);
      *(u32x2*)(ST + (long)c * 8192) = u32x2{pack2(st[0], st[1]), pack2(st[2], st[3])};
      st[0] = st[0] * dec.x + lo2f(loc.x);
      st[1] = st[1] * dec.y + hi2f(loc.x);
      st[2] = st[2] * dec.z + lo2f(loc.y);
      st[3] = st[3] * dec.w + hi2f(loc.y);
    }
  }
}

DI void gla_out_item(const P& p, int item, char* smem) {
  const int tid = threadIdx.x, lane = tid & 63, w = tid >> 6, r16 = lane & 15, quad = lane >> 4;
  const int bh = item >> 7, c = item & 127, b = bh >> 2, h = bh & 3;
  const long t0 = (long)b * S_ + c * 64;
  bf16_t* sQ = (bf16_t*)smem;
  bf16_t* sK = (bf16_t*)(smem + 9216);
  bf16_t* sVT = (bf16_t*)(smem + 18432);
  bf16_t* sST = (bf16_t*)(smem + 36864);
  float* sG = (float*)(smem + 36864);
  float* sTot = (float*)(smem + 36864 + 4096);
  __syncthreads();
  const int d = tid & 63, seg = tid >> 6;
  const bf16_t* gq = (const bf16_t*)(p.ws + OFF_GLQ) + (t0 + seg * 16) * 256 + h * 64 + d;
  const bf16_t* gk = (const bf16_t*)(p.ws + OFF_GLK) + (t0 + seg * 16) * 256 + h * 64 + d;
  bf16_t qraw[16], kraw[16];
#pragma unroll
  for (int tt = 0; tt < 16; tt++) { qraw[tt] = gq[(long)tt * 256]; kraw[tt] = gk[(long)tt * 256]; }
  unsigned vpk[16];
  gla_fetch_v(p, h, t0, vpk);
  u32x4 straw[4];
  {
    const bf16_t* ST = (const bf16_t*)((const char*)p.out + OUT_ST) + (long)item * 8192;
#pragma unroll
    for (int i = 0; i < 4; i++) {
      const int cidx = tid + 256 * i, row = cidx >> 3, kc = (cidx & 7) * 8;
      straw[i] = *(const u32x4*)(ST + row * 64 + kc);
    }
  }
  float bl[16], btot;
  gla_compute_b(p, h, t0, bl, btot, sG, sTot);
#pragma unroll
  for (int tt = 0; tt < 16; tt++) {
    const float eb = __expf(bl[tt]);
    sQ[(seg * 16 + tt) * LDT + d] = f2bf(bf2f(qraw[tt]) * eb);
    sK[(seg * 16 + tt) * LDT + d] = f2bf(bf2f(kraw[tt]) * frcp(eb));
  }
  gla_store_v(sVT, vpk);
  __syncthreads();
#pragma unroll
  for (int i = 0; i < 4; i++) {
    const int cidx = tid + 256 * i, row = cidx >> 3, kc = (cidx & 7) * 8;
    *(u32x4*)(sST + row * LDT + kc) = straw[i];
  }
  __syncthreads();
  const int t = 16 * w + r16;
  bf16x8 qf[2];
#pragma unroll
  for (int ks = 0; ks < 2; ks++) qf[ks] = *(const bf16x8*)(sQ + t * LDT + ks * 32 + quad * 8);
  f32x4 a[4];
#pragma unroll
  for (int mt = 0; mt < 4; mt++) a[mt] = f32x4{0.f, 0.f, 0.f, 0.f};
#pragma unroll
  for (int ks = 0; ks < 2; ks++)
#pragma unroll
    for (int mt = 0; mt < 4; mt++) {
      bf16x8 kf = *(const bf16x8*)(sK + (16 * mt + r16) * LDT + ks * 32 + quad * 8);
      a[mt] = mfma16(kf, qf[ks], a[mt]);
    }
#pragma unroll
  for (int mt = 0; mt < 4; mt++)
#pragma unroll
    for (int i = 0; i < 4; i++)
      if (16 * mt + 4 * quad + i > t) a[mt][i] = 0.f;
  bf16x8 pf[2];
#pragma unroll
  for (int ks2 = 0; ks2 < 2; ks2++) {
    pf[ks2] = pack8_mfma(a[2 * ks2][0], a[2 * ks2][1], a[2 * ks2][2], a[2 * ks2][3], a[2 * ks2 + 1][0], a[2 * ks2 + 1][1], a[2 * ks2 + 1][2], a[2 * ks2 + 1][3]);
  }
  f32x4 o[8];
  float ss = 0.f;
#pragma unroll
  for (int et = 0; et < 8; et++) {
    f32x4 acc = f32x4{0.f, 0.f, 0.f, 0.f};
#pragma unroll
    for (int ks = 0; ks < 2; ks++) {
      bf16x8 sf = *(const bf16x8*)(sST + (16 * et + r16) * LDT + ks * 32 + quad * 8);
      acc = mfma16(sf, qf[ks], acc);
    }
#pragma unroll
    for (int ks2 = 0; ks2 < 2; ks2++) {
      const bf16_t* vp = sVT + (16 * et + r16) * LDT + 32 * ks2 + 4 * quad;
      s16x4 lo = *(const s16x4*)vp, hi = *(const s16x4*)(vp + 16);
      bf16x8 vf = __builtin_shufflevector(lo, hi, 0, 1, 2, 3, 4, 5, 6, 7);
      acc = mfma16(vf, pf[ks2], acc);
    }
    o[et] = acc;
#pragma unroll
    for (int i = 0; i < 4; i++) ss += acc[i] * acc[i];
  }
  ss = quadsum(ss);
  const float rs = rsqrtf(ss * (1.f / 128.f) + EPS);
  bf16_t* R = (bf16_t*)(p.ws + OFF_GLR) + (t0 + t) * 512 + h * 128;
#pragma unroll
  for (int et = 0; et < 8; et++) {
    const int e = 16 * et + 4 * quad;
    const f32x4 ww = *(const f32x4*)(p.gla_out_norm_w + e);
    const u32x2 rr = *(const u32x2*)(R + e);
    const float r0 = lo2f(rr.x), r1 = hi2f(rr.x), r2 = lo2f(rr.y), r3 = hi2f(rr.y);
    const float y0 = o[et][0] * rs * ww.x * (r0 / (1.f + __expf(-r0)));
    const float y1 = o[et][1] * rs * ww.y * (r1 / (1.f + __expf(-r1)));
    const float y2 = o[et][2] * rs * ww.z * (r2 / (1.f + __expf(-r2)));
    const float y3 = o[et][3] * rs * ww.w * (r3 / (1.f + __expf(-r3)));
    *(u32x2*)(R + e) = u32x2{pack2(y0, y1), pack2(y2, y3)};
  }
}

constexpr int N_P2_ITEMS = 12288;
#ifndef P2_SUB
#define P2_SUB 7
#endif
#define P2S(n) (((P2_SUB) >> (n)) & 1)
DI void phase2_item(const P& p, int item, char* smem) {
  char* ws = p.ws;
  if (P2S(0) && item < 4096) {
    const int qb = 127 - (item >> 5), bh = item & 31, b = bh >> 2, h = bh & 3;
    const long trow = (long)b * S_ + qb * 64;
    const float slope = exp2f(-2.f * (float)(h + 1));
    const float lam = ((const float*)(ws + OFF_MISC))[0];
    bf16_t* Q = (bf16_t*)(ws + OFF_DAQ) + trow * 512 + h * 128;
    const bf16_t* Kp = (const bf16_t*)(ws + OFF_DAK) + (long)b * S_ * 512 + h * 128;
    const bf16_t* VT = (const bf16_t*)(ws + OFF_DAVT) + (long)(b * 4 + h) * 128 * S_;
    const float mfix = ((const float*)(ws + OFF_MISC))[1];
    if (mfix <= 40.f)
      attn_item<64, 2, true, true, true>(Q, 512, Kp, 512, VT, S_, qb + 1, qb * 64, slope * LOG2E, lam, p.da_out_norm_w, 0.8f, Q, 512, (bf16_t*)smem,
                                         (bf16_t*)(smem + 64 * LDK * 2), mfix);
    else
      attn_item<64, 2, true, true, false>(Q, 512, Kp, 512, VT, S_, qb + 1, qb * 64, slope * LOG2E, lam, p.da_out_norm_w, 0.8f, Q, 512, (bf16_t*)smem,
                                          (bf16_t*)(smem + 64 * LDK * 2), 0.f);
  } else if (P2S(1) && item < 8192) {
    const int it = item - 4096, qb = it >> 5, bh = it & 31, b = bh >> 2, h = bh & 3;
    const long trow = (long)b * S_ + qb * 64;
    bf16_t* Q = (bf16_t*)(ws + OFF_XAQ) + trow * 512 + h * 128;
    const bf16_t* Kp = (const bf16_t*)(ws + OFF_MK) + (long)b * 256 * 512 + h * 128;
    const bf16_t* VT = (const bf16_t*)(ws + OFF_MVT) + (long)(b * 4 + h) * 128 * 256;
    attn_item<128, 1, false, false, false>(Q, 512, Kp, 512, VT, 256, 4, 0, 0.f, 0.f, nullptr, 1.f, Q, 512, (bf16_t*)smem, (bf16_t*)(smem + 64 * LDK * 2), 0.f);
  } else if (P2S(2)) {
    { const int it = item - 8192; gla_local_item(p, (it & 31) * 128 + (it >> 5), smem); }
  }
}

DI void phase5_tile(const P& p, int tile, bf16_t* sA, bf16_t* sB, u32x2* sM) {
  const int tid = threadIdx.x, lane = tid & 63, w = tid >> 6, r16 = lane & 15, quad = lane >> 4;
  char* ws = p.ws;
  const int xcd = tile & 7, j = tile >> 3, mp = (j >> 3) * 8 + xcd, nt_ = j & 7;
  const long m0 = (long)mp * 128;
  bf16_t* dst = (bf16_t*)(ws + OFF_MERGED) + m0 * 1024 + nt_ * 128;
  u32x2 merged[2][8];
#pragma unroll
  for (int mt = 0; mt < 2; mt++)
#pragma unroll
    for (int nt = 0; nt < 8; nt++) merged[mt][nt] = u32x2{0u, 0u};
#pragma unroll 1
  for (int br = 0; br < 3; br++) {
    u32x2 ob[2][8];
    {
      f32x4 acc[2][8];
      zero_acc(acc);
      const size_t oo = br == 0 ? OFF_DAQ : (br == 1 ? OFF_GLR : OFF_XAQ);
      gemm_tile<64, 2>((const bf16_t*)(ws + oo) + m0 * 512, 512, (const bf16_t*)(ws + OFF_WBR + br * MiB) + (long)nt_ * 128 * 512, 512, 512, acc, (char*)sA);
#pragma unroll
      for (int mt = 0; mt < 2; mt++)
#pragma unroll
        for (int nt = 0; nt < 8; nt++) ob[mt][nt] = u32x2{pack2(acc[mt][nt][0], acc[mt][nt][1]), pack2(acc[mt][nt][2], acc[mt][nt][3])};
    }
    __builtin_amdgcn_sched_barrier(0);
    f32x4 acc[2][8];
    zero_acc(acc);
    gemm_tile<64, 2>((const bf16_t*)((const char*)p.out + OUT_XN) + m0 * 1024, 1024, (const bf16_t*)(ws + OFF_WG) + (long)(br * 1024 + nt_ * 128) * 1024, 1024, 1024,
              acc, (char*)sA);
    __builtin_amdgcn_sched_barrier(0);
#pragma unroll
    for (int mt = 0; mt < 2; mt++) {
#pragma unroll
      for (int nt = 0; nt < 8; nt++) {
        const u32x2 mg = merged[mt][nt];
        const float v0 = lo2f(mg.x) + lo2f(ob[mt][nt].x) * frcp(1.f + __expf(-acc[mt][nt][0]));
        const float v1 = hi2f(mg.x) + hi2f(ob[mt][nt].x) * frcp(1.f + __expf(-acc[mt][nt][1]));
        const float v2 = lo2f(mg.y) + lo2f(ob[mt][nt].y) * frcp(1.f + __expf(-acc[mt][nt][2]));
        const float v3 = hi2f(mg.y) + hi2f(ob[mt][nt].y) * frcp(1.f + __expf(-acc[mt][nt][3]));
        merged[mt][nt] = u32x2{pack2(v0, v1), pack2(v2, v3)};
        __builtin_amdgcn_sched_barrier(0);
      }
    }
  }
#pragma unroll
  for (int mt = 0; mt < 2; mt++) {
    const int m = 32 * w + 16 * mt + r16;
#pragma unroll
    for (int nt = 0; nt < 8; nt++) *(u32x2*)(dst + (long)m * 1024 + 16 * nt + 4 * quad) = merged[mt][nt];
  }
}
DI void phase6_tile(const P& p, int tile, bf16_t* sA, bf16_t* sB) {
  const int tid = threadIdx.x, lane = tid & 63, w = tid >> 6, r16 = lane & 15, quad = lane >> 4;
  char* ws = p.ws;
  const int xcd = tile & 7, j = tile >> 3, mp = (j >> 3) * 8 + xcd, nt_ = j & 7;
  const long m0 = (long)mp * 128;
  f32x4 acc[2][8];
  zero_acc(acc);
  gemm_tile<64, 2>((const bf16_t*)(ws + OFF_MERGED) + m0 * 1024, 1024, (const bf16_t*)(ws + OFF_WOUT) + (long)nt_ * 128 * 1024, 1024, 1024, acc, (char*)sA);
#pragma unroll
  for (int mt = 0; mt < 2; mt++) {
    const long m = m0 + 32 * w + 16 * mt + r16;
    float ss = 0.f;
#pragma unroll
    for (int nt = 0; nt < 8; nt++) {
      const int col = nt_ * 128 + 16 * nt + 4 * quad;
      const f32x4 xv = *(const f32x4*)(p.x + m * 1024 + col);
      const f32x4 y = f32x4{xv.x + acc[mt][nt][0], xv.y + acc[mt][nt][1], xv.z + acc[mt][nt][2], xv.w + acc[mt][nt][3]};
      *(f32x4*)(p.out + m * 1024 + col) = y;
      const f32x4 ww = *(const f32x4*)(p.ffn_norm_w + col);
      *(u32x2*)((bf16_t*)(ws + OFF_XN2) + m * 1024 + col) = u32x2{pack2(y.x * ww.x, y.y * ww.y), pack2(y.z * ww.z, y.w * ww.w)};
      ss += y.x * y.x + y.y * y.y + y.z * y.z + y.w * y.w;
    }
    ss = quadsum(ss);
    if (quad == 0) atomicAdd((float*)(ws + OFF_ROWSS) + m, ss);
  }
}

constexpr int LDSK = 136;
DI void peer_topk_item(const P& p, int item, char* smem) {
  const int tid = threadIdx.x, lane = tid & 63, w = tid >> 6, r16 = lane & 15, quad = lane >> 4;
  char* ws = p.ws;
  const int xcd = item & 7, j = item >> 3, mp = (j >> 3) * 8 + xcd, h = j & 7;
  const long m0 = (long)mp * 128;
  bf16_t* sA = (bf16_t*)smem;
  bf16_t* sB = (bf16_t*)(smem + 128 * LDT * 2);
  bf16_t* sSK = (bf16_t*)smem;
  float* sTopV = (float*)(smem + 36864);
  int* sTopI = (int*)(smem + 36864 + 16384);
#pragma unroll 1
  for (int pp = 0; pp < 2; pp++) {
    f32x4 acc[2][8];
    zero_acc(acc);
    gemm_tile<32, 2>((const bf16_t*)(ws + OFF_XN2) + m0 * 1024, 1024, (const bf16_t*)(ws + OFF_WQ) + (long)(h * 256 + pp * 128) * 1024, 1024, 1024, acc, (char*)sA);
    bf16x8 qf[2][4];
#pragma unroll
    for (int mt = 0; mt < 2; mt++)
#pragma unroll
      for (int ks = 0; ks < 4; ks++)
        qf[mt][ks] = pack8_mfma(acc[mt][2 * ks][0], acc[mt][2 * ks][1], acc[mt][2 * ks][2], acc[mt][2 * ks][3], acc[mt][2 * ks + 1][0], acc[mt][2 * ks + 1][1],
                                acc[mt][2 * ks + 1][2], acc[mt][2 * ks + 1][3]);
    __builtin_amdgcn_sched_barrier(0);
    __syncthreads();
    {
      const bf16_t* SK = (const bf16_t*)(ws + OFF_SUBK) + pp * 128 * 128;
#pragma unroll
      for (int i = 0; i < 8; i++) {
        const int cidx = tid + 256 * i, row = cidx >> 4, kc = (cidx & 15) * 8;
        *(u32x4*)(sSK + row * LDSK + kc) = *(const u32x4*)(SK + row * 128 + kc);
      }
    }
    __syncthreads();
#pragma unroll
    for (int mt = 0; mt < 2; mt++) {
      f32x4 sc[8];
#pragma unroll
      for (int nt = 0; nt < 8; nt++) sc[nt] = f32x4{0.f, 0.f, 0.f, 0.f};
#pragma unroll
      for (int ks = 0; ks < 4; ks++) {
#pragma unroll
        for (int nt = 0; nt < 8; nt++) {
          const bf16_t* kp = sSK + (16 * nt + r16) * LDSK + 32 * ks + 4 * quad;
          s16x4 lo = *(const s16x4*)kp, hi = *(const s16x4*)(kp + 16);
          bf16x8 kf = __builtin_shufflevector(lo, hi, 0, 1, 2, 3, 4, 5, 6, 7);
          sc[nt] = mfma16(kf, qf[mt][ks], sc[nt]);
        }
        __builtin_amdgcn_sched_barrier(0);
      }
      const int tok = 32 * w + 16 * mt + r16;
      unsigned key[8][4];
#pragma unroll
      for (int nt = 0; nt < 8; nt++)
#pragma unroll
        for (int i = 0; i < 4; i++) {
          const unsigned bits = __float_as_uint(sc[nt][i]);
          const unsigned srt = bits ^ ((unsigned)((int)bits >> 31) | 0x80000000u);
          key[nt][i] = (srt & 0xffffff80u) | (unsigned)(127 - 16 * nt - i - 4 * quad);
        }
#pragma unroll 1
      for (int r = 0; r < 16; r++) {
        unsigned gm = 0u;
#pragma unroll
        for (int nt = 0; nt < 8; nt++)
#pragma unroll
          for (int i = 0; i < 4; i++) gm = max(gm, key[nt][i]);
        gm = max(gm, (unsigned)__shfl_xor((int)gm, 16));
        gm = max(gm, (unsigned)__shfl_xor((int)gm, 32));
        if (quad == 0) {
          const unsigned srt = gm & 0xffffff80u;
          const unsigned bits = (srt & 0x80000000u) ? (srt ^ 0x80000000u) : ~srt;
          sTopV[(pp * 128 + tok) * 16 + r] = __uint_as_float(bits);
          sTopI[(pp * 128 + tok) * 16 + r] = 127 - (int)(gm & 0x7fu);
        }
#pragma unroll
        for (int nt = 0; nt < 8; nt++)
#pragma unroll
          for (int i = 0; i < 4; i++)
            if (key[nt][i] == gm) key[nt][i] = 0u;
      }
      __builtin_amdgcn_sched_barrier(0);
    }
  }
  __syncthreads();
  if (tid < 128) {
    const int tok = tid;
    float a[16], b[16];
#pragma unroll
    for (int i = 0; i < 16; i++) { a[i] = sTopV[tok * 16 + i]; b[i] = sTopV[(128 + tok) * 16 + i]; }
    unsigned cand[50];
    {
      int q = 0;
#pragma unroll
      for (int i = 0; i < 16; i++)
#pragma unroll
        for (int jj = 0; jj < 16; jj++)
          if ((i + 1) * (jj + 1) <= 16) {
            const unsigned bits = __float_as_uint(a[i] + b[jj]);
            const unsigned srt = bits ^ ((unsigned)((int)bits >> 31) | 0x80000000u);
            cand[q] = (srt & 0xffffff00u) | (unsigned)(255 - (i * 16 + jj));
            q++;
          }
    }
    int* PIDX = (int*)(ws + OFF_PIDX) + ((m0 + tok) * 8 + h) * 16;
    float* PG = (float*)(ws + OFF_PG) + ((m0 + tok) * 8 + h) * 16;
    float top0 = 0.f, gsum = 0.f;
    const float rstd_t = rsqrtf(((const float*)(ws + OFF_ROWSS))[m0 + tok] * (1.f / 1024.f) + EPS);
#pragma unroll 1
    for (int r = 0; r < 16; r++) {
      unsigned gm = 0u;
#pragma unroll
      for (int q = 0; q < 50; q++) gm = max(gm, cand[q]);
#pragma unroll
      for (int q = 0; q < 50; q++)
        if (cand[q] == gm) cand[q] = 0u;
      const unsigned srt = gm & 0xffffff00u;
      const float bv = __uint_as_float((srt & 0x80000000u) ? (srt ^ 0x80000000u) : ~srt);
      const int bc = 255 - (int)(gm & 0xffu);
      if (r == 0) top0 = bv;
      const float e = __expf((bv - top0) * rstd_t);
      gsum += e;
      PIDX[r] = sTopI[tok * 16 + (bc >> 4)] * 128 + sTopI[(128 + tok) * 16 + (bc & 15)];
      PG[r] = e;
    }
    const float ginv = 1.f / gsum;
#pragma unroll 1
    for (int r = 0; r < 16; r++) PG[r] *= ginv;
  }
}

typedef float f32x2 __attribute__((ext_vector_type(2)));
DI float dot16_fp8(u32x4 u, const float* xf) {
  float s = 0.f;
#pragma unroll
  for (int j = 0; j < 4; j++) {
    const f32x2 lo = __builtin_amdgcn_cvt_pk_f32_fp8((int)u[j], false), hi = __builtin_amdgcn_cvt_pk_f32_fp8((int)u[j], true);
    s += lo.x * xf[4 * j];
    s += lo.y * xf[4 * j + 1];
    s += hi.x * xf[4 * j + 2];
    s += hi.y * xf[4 * j + 3];
  }
  return s;
}
DI void fma16_fp8(float* o, u32x4 v, float c) {
#pragma unroll
  for (int j = 0; j < 4; j++) {
    const f32x2 lo = __builtin_amdgcn_cvt_pk_f32_fp8((int)v[j], false), hi = __builtin_amdgcn_cvt_pk_f32_fp8((int)v[j], true);
    o[4 * j] += c * lo.x;
    o[4 * j + 1] += c * lo.y;
    o[4 * j + 2] += c * hi.x;
    o[4 * j + 3] += c * hi.y;
  }
}
typedef _Float16 v32h_ __attribute__((ext_vector_type(32)));
typedef _Float16 h2_ __attribute__((ext_vector_type(2)));
typedef float v16f_ __attribute__((ext_vector_type(16)));
typedef unsigned v6u_ __attribute__((ext_vector_type(6)));
typedef unsigned u32x3_ __attribute__((ext_vector_type(3)));
DI void quant_rows_fp6(const float* __restrict__ src, unsigned* __restrict__ dst, float* __restrict__ scales, int nrows, int gwave, int nwaves) {
  const int lane = threadIdx.x & 63;
  for (int r2 = gwave; r2 < nrows / 2; r2 += nwaves) {
    v16f_ ab[2];
#pragma unroll
    for (int q = 0; q < 2; q++) {
      const int r = 2 * r2 + q;
      const f32x4* s4 = (const f32x4*)(src + (long)r * 1024 + lane * 16);
      f32x4 v[4];
      float am = 0.f;
#pragma unroll
      for (int j = 0; j < 4; j++) {
        v[j] = s4[j];
        am = fmaxf(am, fmaxf(fmaxf(fabsf(v[j].x), fabsf(v[j].y)), fmaxf(fabsf(v[j].z), fabsf(v[j].w))));
      }
#pragma unroll
      for (int o = 32; o > 0; o >>= 1) am = fmaxf(am, __shfl_xor(am, o));
      const float sc = am > 0.f ? am * (1.f / 7.5f) : 1.f;
      const float inv = 1.f / sc;
#pragma unroll
      for (int j = 0; j < 4; j++) { ab[q][4 * j] = v[j].x * inv; ab[q][4 * j + 1] = v[j].y * inv; ab[q][4 * j + 2] = v[j].z * inv; ab[q][4 * j + 3] = v[j].w * inv; }
      if (lane == 0) scales[r] = sc;
    }
    v16f_ ev, od;
#pragma unroll
    for (int i = 0; i < 8; i++) { ev[i] = ab[0][2 * i]; od[i] = ab[0][2 * i + 1]; ev[8 + i] = ab[1][2 * i]; od[8 + i] = ab[1][2 * i + 1]; }
    const v6u_ e = __builtin_amdgcn_cvt_scalef32_2xpk16_fp6_f32(ev, od, 1.0f);
    *(u32x3_*)(dst + (long)(2 * r2) * 192 + lane * 3) = u32x3_{e[0], e[1], e[2]};
    *(u32x3_*)(dst + (long)(2 * r2 + 1) * 192 + lane * 3) = u32x3_{e[3], e[4], e[5]};
  }
}
DI void peer_eval(const P& p) {
  const int lane = threadIdx.x & 63;
  const int gwave = blockIdx.x * 4 + (threadIdx.x >> 6), nwaves = gridDim.x * 4;
  const unsigned* U = (const unsigned*)(p.ws + OFF_U);
  const unsigned* V = (const unsigned*)(p.ws + OFF_V);
  const float* SU = (const float*)(p.ws + OFF_SU);
  const float* SV = (const float*)(p.ws + OFF_SV);
  const int myk = (lane >> 2) & 15;
  for (int t = gwave; t < T_; t += nwaves) {
    const u32x4* xr = (const u32x4*)((const bf16_t*)(p.ws + OFF_XN2) + (long)t * 1024 + lane * 16);
    const u32x4 x0 = xr[0], x1 = xr[1];
    h2_ xh[8];
    xh[0] = h2_{(_Float16)lo2f(x0.x), (_Float16)hi2f(x0.x)}; xh[1] = h2_{(_Float16)lo2f(x0.y), (_Float16)hi2f(x0.y)};
    xh[2] = h2_{(_Float16)lo2f(x0.z), (_Float16)hi2f(x0.z)}; xh[3] = h2_{(_Float16)lo2f(x0.w), (_Float16)hi2f(x0.w)};
    xh[4] = h2_{(_Float16)lo2f(x1.x), (_Float16)hi2f(x1.x)}; xh[5] = h2_{(_Float16)lo2f(x1.y), (_Float16)hi2f(x1.y)};
    xh[6] = h2_{(_Float16)lo2f(x1.z), (_Float16)hi2f(x1.z)}; xh[7] = h2_{(_Float16)lo2f(x1.w), (_Float16)hi2f(x1.w)};
    float o[16];
#pragma unroll
    for (int i = 0; i < 16; i++) o[i] = 0.f;
    const float rstd_t = rsqrtf(((const float*)(p.ws + OFF_ROWSS))[t] * (1.f / 1024.f) + EPS);
#pragma unroll 1
    for (int h = 0; h < 8; h++) {
      const int eidx = ((const int*)(p.ws + OFF_PIDX))[((long)t * 8 + h) * 16 + myk];
      const float g = ((const float*)(p.ws + OFF_PG))[((long)t * 8 + h) * 16 + myk];
      const float su = SU[eidx], sv = SV[eidx];
      float part[16];
      u32x3_ raw[16];
#pragma unroll
      for (int k = 0; k < 16; k++) {
        const int e = __builtin_amdgcn_readlane(eidx, 4 * k);
        raw[k] = *(const u32x3_*)(U + (long)e * 192 + lane * 3);
      }
#pragma unroll
      for (int k2 = 0; k2 < 8; k2++) {
        const v32h_ d = __builtin_amdgcn_cvt_scalef32_pk32_f16_fp6(v6u_{raw[2 * k2][0], raw[2 * k2][1], raw[2 * k2][2], raw[2 * k2 + 1][0], raw[2 * k2 + 1][1], raw[2 * k2 + 1][2]}, 1.0f);
        float s0 = 0.f, s1 = 0.f;
#pragma unroll
        for (int j = 0; j < 8; j++) {
          s0 = __builtin_amdgcn_fdot2(h2_{d[2 * j], d[2 * j + 1]}, xh[j], s0, false);
          s1 = __builtin_amdgcn_fdot2(h2_{d[16 + 2 * j], d[17 + 2 * j]}, xh[j], s1, false);
        }
        part[2 * k2] = s0;
        part[2 * k2 + 1] = s1;
      }
      float p8[8], p4[4], p2[2], p1;
      {
        const bool hb = (lane & 32) != 0;
#pragma unroll
        for (int k = 0; k < 8; k++) { const float keep = hb ? part[k + 8] : part[k], send = hb ? part[k] : part[k + 8]; p8[k] = keep + __shfl_xor(send, 32); }
      }
      {
        const bool hb = (lane & 16) != 0;
#pragma unroll
        for (int k = 0; k < 4; k++) { const float keep = hb ? p8[k + 4] : p8[k], send = hb ? p8[k] : p8[k + 4]; p4[k] = keep + __shfl_xor(send, 16); }
      }
      {
        const bool hb = (lane & 8) != 0;
#pragma unroll
        for (int k = 0; k < 2; k++) { const float keep = hb ? p4[k + 2] : p4[k], send = hb ? p4[k] : p4[k + 2]; p2[k] = keep + __shfl_xor(send, 8); }
      }
      {
        const bool hb = (lane & 4) != 0;
        const float keep = hb ? p2[1] : p2[0], send = hb ? p2[0] : p2[1];
        p1 = keep + __shfl_xor(send, 4);
      }
      p1 += __shfl_xor(p1, 1);
      p1 += __shfl_xor(p1, 2);
      p1 *= su * rstd_t;
      const float act = 0.5f * p1 * (1.f + erff(p1 * 0.70710678118654752f));
      const float coef = g * act * sv;
#pragma unroll
      for (int k = 0; k < 16; k++) {
        const int e = __builtin_amdgcn_readlane(eidx, 4 * k);
        raw[k] = *(const u32x3_*)(V + (long)e * 192 + lane * 3);
      }
#pragma unroll
      for (int k2 = 0; k2 < 8; k2++) {
        const float c0 = __int_as_float(__builtin_amdgcn_readlane(__float_as_int(coef), 8 * k2)), c1 = __int_as_float(__builtin_amdgcn_readlane(__float_as_int(coef), 8 * k2 + 4));
        const v32h_ d = __builtin_amdgcn_cvt_scalef32_pk32_f16_fp6(v6u_{raw[2 * k2][0], raw[2 * k2][1], raw[2 * k2][2], raw[2 * k2 + 1][0], raw[2 * k2 + 1][1], raw[2 * k2 + 1][2]}, 1.0f);
#pragma unroll
        for (int j = 0; j < 16; j++) { o[j] += c0 * (float)d[j]; o[j] += c1 * (float)d[16 + j]; }
      }
    }
    f32x4* orow = (f32x4*)(p.out + (long)t * 1024 + lane * 16);
#pragma unroll
    for (int j = 0; j < 4; j++) {
      const f32x4 a = orow[j];
      orow[j] = f32x4{a.x + o[4 * j], a.y + o[4 * j + 1], a.z + o[4 * j + 2], a.w + o[4 * j + 3]};
    }
  }
}

#define XB_TMO      128
#define XB_XCNT(j)  (256  + 64 * (j))
#define XB_XSUB(j)  (1280 + 64 * (j))
#define XB_XGEN(j)  (2304 + 64 * (j))
#define XB_TOP      3328
#define XB_TOPGEN   3392
#define XCD_BAR_WORDS 3456
#define XB_SPIN_CAP (1u << 18)
#define LAS __attribute__((address_space(3)))
DI unsigned xb_ld(unsigned* p) { return __hip_atomic_load(p, __ATOMIC_RELAXED, __HIP_MEMORY_SCOPE_AGENT); }
DI unsigned xb_add(unsigned* p, unsigned v) { return __hip_atomic_fetch_add(p, v, __ATOMIC_RELAXED, __HIP_MEMORY_SCOPE_AGENT); }
DI unsigned xb_xcc_id() { return (unsigned)__builtin_amdgcn_s_getreg((3 << 11) | 20) & 0xFu; }
#define XB_SPIN(cond, bar) do { unsigned _sp = 0; while (cond) { __builtin_amdgcn_s_sleep(1); \
    if ((++_sp & 255u) == 0u) { if (xb_ld(&(bar)[XB_TMO])) break; if (_sp > XB_SPIN_CAP) { atomicAdd(&(bar)[XB_TMO], 1u); break; } } } } while (0)
struct XcdBarrier { unsigned* bar; unsigned x; volatile LAS unsigned* st; };
DI XcdBarrier xcd_barrier_post(unsigned* bar, volatile LAS unsigned* st) {
  XcdBarrier b; b.bar = bar; b.x = xb_xcc_id(); b.st = st;
  if (threadIdx.x == 0) (void)xb_add(&bar[XB_XCNT(b.x)], 1u);
  return b;
}
DI void xcd_barrier_complete(unsigned* bar, unsigned x, unsigned& nloc, unsigned& nx) {
  const unsigned G = gridDim.x * gridDim.y * gridDim.z;
  unsigned sum, cnt, mine, sp = 0u;
  for (;;) {
    sum = 0u; cnt = 0u; mine = 0u;
#pragma unroll
    for (unsigned j = 0; j < 16; ++j) { const unsigned c = xb_ld(&bar[XB_XCNT(j)]); sum += c; cnt += (c > 0u) ? 1u : 0u; mine = (j == x) ? c : mine; }
    if (sum == G) break;
    __builtin_amdgcn_s_sleep(1);
    if ((++sp & 255u) == 0u) { if (xb_ld(&bar[XB_TMO])) break; if (sp > XB_SPIN_CAP) { atomicAdd(&bar[XB_TMO], 1u); break; } }
  }
  nloc = mine > 0u ? mine : 1u; nx = cnt > 0u ? cnt : 1u;
}
DI void xcd_barrier(const XcdBarrier& b) {
  asm volatile("s_waitcnt vmcnt(0)" ::: "memory");
  __syncthreads();
  if (threadIdx.x == 0) {
    unsigned* bar = b.bar;
    __builtin_amdgcn_s_waitcnt(0);
    unsigned nloc = b.st[0], nx = b.st[1];
    if (nloc == 0u) { xcd_barrier_complete(bar, b.x, nloc, nx); b.st[0] = nloc; b.st[1] = nx; }
    const unsigned old = xb_add(&bar[XB_XSUB(b.x)], 1u);
    const unsigned gen = old / nloc;
    if (old + 1u == (gen + 1u) * nloc) {
      __builtin_amdgcn_fence(__ATOMIC_RELEASE, "agent");
      asm volatile("s_waitcnt vmcnt(0)" ::: "memory");
      const unsigned og = xb_add(&bar[XB_TOP], 1u);
      const unsigned tg = og / nx;
      if (og + 1u == (tg + 1u) * nx) xb_add(&bar[XB_TOPGEN], 1u);
      else XB_SPIN(xb_ld(&bar[XB_TOPGEN]) == tg, bar);
      __builtin_amdgcn_fence(__ATOMIC_ACQUIRE, "agent");
      xb_add(&bar[XB_XGEN(b.x)], 1u);
      asm volatile("s_waitcnt vmcnt(0)" ::: "memory");
    } else {
      XB_SPIN(xb_ld(&bar[XB_XGEN(b.x)]) == gen, bar);
      __builtin_amdgcn_fence(__ATOMIC_ACQUIRE, "agent");
      asm volatile("s_waitcnt vmcnt(0)" ::: "memory");
    }
  }
  __syncthreads();
}
constexpr size_t OFF_XBAR = OFF_MISC + 16384;

#ifndef PH_MASK
#define PH_MASK 0x3ff
#endif
#define PH_ON(n) (((PH_MASK) >> (n)) & 1)
constexpr int SMEM_BYTES = 69632;
__global__ void __launch_bounds__(256, 2) mega(P p) {
  __shared__ __attribute__((aligned(16))) char smem[SMEM_BYTES];
  __shared__ int s_item;
  cg::grid_group grid = cg::this_grid();
  __shared__ __attribute__((aligned(16))) unsigned xb_words[4];
  if (threadIdx.x < 4) xb_words[threadIdx.x] = 0u;
  __syncthreads();
  const XcdBarrier xb = xcd_barrier_post((unsigned*)(p.ws + OFF_XBAR), (volatile LAS unsigned*)&xb_words);
  bf16_t* sA = (bf16_t*)smem;
  bf16_t* sB = (bf16_t*)(smem + 128 * LDT * 2);
  const int lo = p.phase_lo, hi = p.phase_hi;
#define PH_RUN(n) (PH_ON(n) && lo <= (n) && (n) <= hi)
#ifndef PROBE_PHASE
#define PROBE_PHASE -1
#endif
#ifndef PROBE_PHASE2
#define PROBE_PHASE2 -5
#endif
#define PH_SYNC(n) if (lo <= (n) && (n) < hi) { xcd_barrier(xb); } \
  if (PROBE_PHASE >= 0 && blockIdx.x == 0 && threadIdx.x == 0) { \
    if ((n) == PROBE_PHASE - 1) ((unsigned long long*)(p.ws + OFF_MISC))[16] = __builtin_amdgcn_s_memrealtime(); \
    if ((n) == PROBE_PHASE) ((unsigned long long*)(p.ws + OFF_MISC))[17] = __builtin_amdgcn_s_memrealtime(); \
    if ((n) == PROBE_PHASE2 - 1) ((unsigned long long*)(p.ws + OFF_MISC))[18] = __builtin_amdgcn_s_memrealtime(); \
    if ((n) == PROBE_PHASE2) ((unsigned long long*)(p.ws + OFF_MISC))[19] = __builtin_amdgcn_s_memrealtime(); }
  if (PROBE_PHASE == 0 && blockIdx.x == 0 && threadIdx.x == 0) ((unsigned long long*)(p.ws + OFF_MISC))[16] = __builtin_amdgcn_s_memrealtime();
  if (lo > 1000) grid.sync();
  if (PH_RUN(0)) phase0(p);
  PH_SYNC(0)
  if (PH_RUN(1)) {
    for (int t = blockIdx.x; t < N_INPROJ_TILES + N_MEMKV_TILES; t += gridDim.x) phase1_tile(p, t, sA, sB);
  }
  PH_SYNC(1)
  if (PH_RUN(2)) {
    const int qx = blockIdx.x & 7;
    unsigned* ctr = (unsigned*)(p.ws + OFF_MISC) + 16 + qx;
    while (true) {
      __syncthreads();
      if (threadIdx.x == 0) s_item = (int)atomicAdd(ctr, 1u);
      __syncthreads();
      const int li = __builtin_amdgcn_readfirstlane(s_item);
      if (li >= 1536) break;
      const int kind = li >> 9, idx = li & 511, bh = 4 * qx + (idx & 3);
      phase2_item(p, kind * 4096 + (idx >> 2) * 32 + bh, smem);
    }
  }
  PH_SYNC(2)
  if (PH_RUN(3)) gla_scan(p);
  PH_SYNC(3)
  if (PH_RUN(4)) {
    for (int it = blockIdx.x; it < 4096; it += gridDim.x) gla_out_item(p, it, smem);
  }
  PH_SYNC(4)
  if (PH_RUN(5)) {
    for (int t = blockIdx.x; t < 4096; t += gridDim.x) phase5_tile(p, t, sA, sB, (u32x2*)(smem + 36864));
  }
  PH_SYNC(5)
  if (PH_RUN(6)) {
    for (int t = blockIdx.x; t < 4096; t += gridDim.x) phase6_tile(p, t, sA, sB);
  }
  PH_SYNC(6)
  if (PH_RUN(8)) {
    for (int it = blockIdx.x; it < 4096; it += gridDim.x) peer_topk_item(p, it, smem);
  }
  PH_SYNC(8)
  if (PH_RUN(9)) peer_eval(p);
  if (PROBE_PHASE != -1) {
    grid.sync();
    if (PROBE_PHASE == 9) {
      if (blockIdx.x == 0 && threadIdx.x == 0) { ((unsigned long long*)(p.ws + OFF_MISC))[17] = __builtin_amdgcn_s_memrealtime(); __threadfence(); }
      grid.sync();
    }
    const unsigned long long* tt = (const unsigned long long*)(p.ws + OFF_MISC);
    float delta = 0.1f;
    if (PROBE_PHASE >= 0) delta = (float)(tt[17] - tt[16]) * (1e-5f / 40.f);
    const long gtid = (long)blockIdx.x * blockDim.x + threadIdx.x, gstride = (long)gridDim.x * blockDim.x;
    for (long t = gtid; t < T_; t += gstride) p.out[t * 1024] += delta;
    if (PROBE_PHASE2 >= 0 && gtid < 16) p.out[gtid * 1024 + 1] += 0.14f + (float)(tt[19] - tt[18]) * (1e-5f * 0.05f);
  }
}

extern "C" void kernel_launch(void* const* d_in, const int* in_sizes, int n_in, void* d_out, int out_size, void* d_ws, size_t ws_size, hipStream_t stream) {
  static int grid_blocks = 0;
  if (!grid_blocks) {
    int dev = 0, cus = 0, per_cu = 0;
    hipGetDevice(&dev);
    hipDeviceGetAttribute(&cus, hipDeviceAttributeMultiprocessorCount, dev);
    hipOccupancyMaxActiveBlocksPerMultiprocessor(&per_cu, mega, 256, 0);
    if (per_cu < 1) per_cu = 1;
    if (per_cu > 2) per_cu = 2;
    grid_blocks = cus * per_cu;
  }
  P p{};
  const float** f = (const float**)&p;
  for (int i = 0; i < 24; i++) f[i] = (const float*)d_in[i];
  p.out = (float*)d_out;
  p.ws = (char*)d_ws;
  p.phase_lo = 0;
  p.phase_hi = 9;
  hipMemsetAsync((char*)d_ws + OFF_XBAR, 0, XCD_BAR_WORDS * sizeof(unsigned), stream);
  void* args[] = {&p};
  hipError_t e = hipLaunchCooperativeKernel((void*)mega, dim3(grid_blocks), dim3(256), args, 0, stream);
  if (e != hipSuccess) fprintf(stderr, "cooperative launch failed: %s (grid %d)\n", hipGetErrorString(e), grid_blocks);
}
```
